# Optimizing an MI355X kernel written in HIP

```python
import math, functools
import jax, jax.numpy as jnp
from jax import lax
import numpy as np

D_MODEL = 1024
BATCH = 4
SEQ = 8192
DEPTH = 2

N_EVEN = (DEPTH + 1) // 2
N_ODD = DEPTH // 2
RMS_EPS = 1e-6

MLA_HEADS = 8
MLA_Q_RANK = 256
MLA_KV_RANK = 128
MLA_NOPE = 64
MLA_ROPE = 32
MLA_V = 64
ROPE_THETA = 10000.0
Q_BLOCK = 128

POOL_WINDOWS = (2, 4, 8, 16)
POOL_GROUP = 128
POOL_WIDTH = POOL_GROUP * len(POOL_WINDOWS)
MIX_AB = MLA_HEADS * MLA_V + POOL_WIDTH
IN_AB = MLA_Q_RANK + MLA_KV_RANK + MLA_ROPE + POOL_WIDTH + MIX_AB

GDN_HEADS = 8
GDN_DK = 128
GDN_DV = 128
CONV_WIDTH = 4
CHUNK = 64
GDN_QK = GDN_HEADS * GDN_DK
GDN_VW = GDN_HEADS * GDN_DV
GDN_CONV_CH = 2 * GDN_QK + GDN_VW
IN_C = GDN_CONV_CH + GDN_VW + 2 * GDN_HEADS

kernel_name = "hybrid_mla_pool_gdn_gated"


def rmsnorm(x, g):
    xf = x.astype(jnp.float32)
    y = xf * lax.rsqrt(jnp.mean(xf * xf, axis=-1, keepdims=True) + RMS_EPS)
    return (y * g.astype(jnp.float32)).astype(x.dtype)


def l2norm(x):
    xf = x.astype(jnp.float32)
    return xf * lax.rsqrt(jnp.sum(xf * xf, axis=-1, keepdims=True) + RMS_EPS)


def rope_tables(positions):
    half = MLA_ROPE // 2
    inv_freq = 1.0 / (ROPE_THETA ** (jnp.arange(half, dtype=jnp.float32) / half))
    ang = positions.astype(jnp.float32)[..., None] * inv_freq
    return jnp.cos(ang), jnp.sin(ang)


def apply_rope(x, cos, sin):
    half = MLA_ROPE // 2
    xf = x.astype(jnp.float32)
    x1, x2 = xf[..., :half], xf[..., half:]
    return jnp.concatenate([x1 * cos - x2 * sin, x2 * cos + x1 * sin], axis=-1).astype(x.dtype)


def mla(q_lat, kv_lat, k_rope, positions, q_a_norm, w_q_b, kv_a_norm, w_kv_b):
    B, S, _ = q_lat.shape
    q = (rmsnorm(q_lat, q_a_norm) @ w_q_b).reshape(B, S, MLA_HEADS, MLA_NOPE + MLA_ROPE)
    q_nope, q_rope = q[..., :MLA_NOPE], q[..., MLA_NOPE:]
    kv = (rmsnorm(kv_lat, kv_a_norm) @ w_kv_b).reshape(B, S, MLA_HEADS, MLA_NOPE + MLA_V)
    k_nope, v = kv[..., :MLA_NOPE], kv[..., MLA_NOPE:]
    cos, sin = rope_tables(positions)
    q_rope = apply_rope(q_rope, cos[:, :, None, :], sin[:, :, None, :])
    k_rope = apply_rope(k_rope, cos, sin)
    scale = (MLA_NOPE + MLA_ROPE) ** -0.5
    nb = S // Q_BLOCK
    qn_b = q_nope.reshape(B, nb, Q_BLOCK, MLA_HEADS, MLA_NOPE).transpose(1, 0, 2, 3, 4)
    qr_b = q_rope.reshape(B, nb, Q_BLOCK, MLA_HEADS, MLA_ROPE).transpose(1, 0, 2, 3, 4)
    key_idx = jnp.arange(S)

    def attend_block(args):
        qn, qr, i = args
        s = (jnp.einsum('bqhd,bkhd->bhqk', qn, k_nope, preferred_element_type=jnp.float32)
             + jnp.einsum('bqhr,bkr->bhqk', qr, k_rope, preferred_element_type=jnp.float32))
        q_idx = i * Q_BLOCK + jnp.arange(Q_BLOCK)
        causal = key_idx[None, :] <= q_idx[:, None]
        p = jax.nn.softmax(jnp.where(causal, s * scale, -jnp.inf), axis=-1)
        return jnp.einsum('bhqk,bkhd->bqhd', p.astype(v.dtype), v)

    o = lax.map(attend_block, (qn_b, qr_b, jnp.arange(nb)))
    return o.transpose(1, 0, 2, 3, 4).reshape(B, S, MLA_HEADS * MLA_V)


def multiscale_pool(xp, pool_w, pool_scale):
    B, S, _ = xp.shape
    xf = xp.astype(jnp.float32)
    csum = jnp.cumsum(xf, axis=1)
    t = jnp.arange(S)
    outs = []
    for g, w in enumerate(POOL_WINDOWS):
        lo, hi = g * POOL_GROUP, (g + 1) * POOL_GROUP
        c = csum[..., lo:hi]
        lagged = jnp.pad(c, ((0, 0), (w, 0), (0, 0)))[:, :S]
        count = jnp.minimum(t + 1, w).astype(jnp.float32)[None, :, None]
        outs.append((c - lagged) / count - xf[..., lo:hi])
    d = jnp.stack(outs, axis=2).astype(xp.dtype)
    y = jnp.einsum('bsgc,gcd->bsgd', d, pool_w).reshape(B, S, POOL_WIDTH)
    return y * pool_scale


def causal_dwconv(x, w):
    S = x.shape[1]
    xp = jnp.pad(x, ((0, 0), (CONV_WIDTH - 1, 0), (0, 0)))
    y = xp[:, 0:S] * w[0]
    for j in range(1, CONV_WIDTH):
        y = y + xp[:, j:j + S] * w[j]
    return y


def chunk_gated_delta(q, k, v, g, beta):
    B, H, S, Dk = q.shape
    Dv = v.shape[-1]
    n = S // CHUNK
    q = (q * Dk ** -0.5).reshape(B, H, n, CHUNK, Dk)
    k = k.reshape(B, H, n, CHUNK, Dk)
    v = v.reshape(B, H, n, CHUNK, Dv)
    beta = beta.reshape(B, H, n, CHUNK)
    gc = jnp.cumsum(g.reshape(B, H, n, CHUNK), axis=-1)
    idx = jnp.arange(CHUNK)
    incl = idx[:, None] >= idx[None, :]
    strict = idx[:, None] > idx[None, :]
    gamma = jnp.exp(jnp.where(incl, gc[..., :, None] - gc[..., None, :], -jnp.inf))
    kb = k * beta[..., None]
    m = jnp.where(strict, jnp.einsum('bhnid,bhnjd->bhnij', kb, k) * gamma, 0.0)
    a_mat = m + jnp.eye(CHUNK, dtype=m.dtype)
    solve = functools.partial(lax.linalg.triangular_solve, left_side=True, lower=True, unit_diagonal=True)
    u = solve(a_mat, v * beta[..., None])
    w = solve(a_mat, kb * jnp.exp(gc)[..., None])
    attn = jnp.einsum('bhnid,bhnjd->bhnij', q, k) * gamma
    q_dec = q * jnp.exp(gc)[..., None]
    k_dec = k * jnp.exp(gc[..., -1:] - gc)[..., None]
    g_last = jnp.exp(gc[..., -1])

    def step(state, inp):
        u_i, w_i, qd_i, kd_i, at_i, gl_i = inp
        v_new = u_i - jnp.einsum('bhck,bhkv->bhcv', w_i, state)
        o_i = jnp.einsum('bhck,bhkv->bhcv', qd_i, state) + jnp.einsum('bhcj,bhjv->bhcv', at_i, v_new)
        state = state * gl_i[..., None, None] + jnp.einsum('bhck,bhcv->bhkv', kd_i, v_new)
        return state, o_i

    mv = lambda a: jnp.moveaxis(a, 2, 0)
    state0 = jnp.zeros((B, H, Dk, Dv), jnp.float32)
    _, o = lax.scan(step, state0, (mv(u), mv(w), mv(q_dec), mv(k_dec), mv(attn), mv(g_last)))
    return jnp.moveaxis(o, 0, 2).reshape(B, H, S, Dv)


def mla_pool_layer(h, positions, w_in, q_a_norm, w_q_b, kv_a_norm, w_kv_b, pool_w, pool_scale, w_out):
    proj = h @ w_in
    o1 = MLA_Q_RANK
    o2 = o1 + MLA_KV_RANK
    o3 = o2 + MLA_ROPE
    o4 = o3 + POOL_WIDTH
    q_lat, kv_lat, k_rope = proj[..., :o1], proj[..., o1:o2], proj[..., o2:o3]
    xp, z = proj[..., o3:o4], proj[..., o4:]
    y_a = mla(q_lat, kv_lat, k_rope, positions, q_a_norm, w_q_b, kv_a_norm, w_kv_b)
    y_b = multiscale_pool(xp, pool_w, pool_scale)
    y = jnp.concatenate([y_a, y_b], axis=-1) * jax.nn.silu(z)
    return y @ w_out


def gdn_layer(h, w_in, conv_w, a_log, dt_bias, o_norm, w_out):
    B, S, _ = h.shape
    proj = h @ w_in
    qkv = jax.nn.silu(causal_dwconv(proj[..., :GDN_CONV_CH], conv_w))
    o1 = GDN_CONV_CH + GDN_VW
    z = proj[..., GDN_CONV_CH:o1]
    a = proj[..., o1:o1 + GDN_HEADS].astype(jnp.float32)
    b = proj[..., o1 + GDN_HEADS:].astype(jnp.float32)
    q = l2norm(qkv[..., :GDN_QK].reshape(B, S, GDN_HEADS, GDN_DK))
    k = l2norm(qkv[..., GDN_QK:2 * GDN_QK].reshape(B, S, GDN_HEADS, GDN_DK))
    v = qkv[..., 2 * GDN_QK:].reshape(B, S, GDN_HEADS, GDN_DV).astype(jnp.float32)
    beta = jax.nn.sigmoid(b)
    g = -jnp.exp(a_log.astype(jnp.float32)) * jax.nn.softplus(a + dt_bias.astype(jnp.float32))
    tr = lambda t: jnp.swapaxes(t, 1, 2)
    o = chunk_gated_delta(tr(q), tr(k), tr(v), tr(g), tr(beta))
    o = rmsnorm(tr(o), o_norm) * jax.nn.silu(z.astype(jnp.float32).reshape(B, S, GDN_HEADS, GDN_DV))
    return o.reshape(B, S, GDN_VW).astype(h.dtype) @ w_out


def setup_inputs(seed: int = 0) -> dict:
    key = jax.random.key(seed)
    ks = jax.random.split(key, 24)
    f32 = jnp.float32

    def dense(k, shape, fan_in):
        return jax.random.normal(k, shape, f32) * fan_in ** -0.5

    def gain(k, shape):
        return 1.0 + 0.02 * jax.random.normal(k, shape, f32)

    x = jax.random.normal(ks[0], (BATCH, SEQ, D_MODEL), f32)
    positions = jnp.broadcast_to(jnp.arange(SEQ, dtype=jnp.int32)[None, :], (BATCH, SEQ))
    dt = jnp.exp(jax.random.uniform(ks[16], (N_ODD, GDN_HEADS), f32, math.log(1e-3), math.log(1e-1)))
    return {
        "x": x,
        "positions": positions,
        "norm_ab": gain(ks[1], (N_EVEN, D_MODEL)),
        "w_in_ab": dense(ks[2], (N_EVEN, D_MODEL, IN_AB), D_MODEL),
        "q_a_norm": gain(ks[3], (N_EVEN, MLA_Q_RANK)),
        "w_q_b": dense(ks[4], (N_EVEN, MLA_Q_RANK, MLA_HEADS * (MLA_NOPE + MLA_ROPE)), MLA_Q_RANK),
        "kv_a_norm": gain(ks[5], (N_EVEN, MLA_KV_RANK)),
        "w_kv_b": dense(ks[6], (N_EVEN, MLA_KV_RANK, MLA_HEADS * (MLA_NOPE + MLA_V)), MLA_KV_RANK),
        "pool_w": dense(ks[7], (N_EVEN, len(POOL_WINDOWS), POOL_GROUP, POOL_GROUP), POOL_GROUP),
        "pool_scale": gain(ks[8], (N_EVEN, POOL_WIDTH)),
        "w_out_ab": dense(ks[9], (N_EVEN, MIX_AB, D_MODEL), MIX_AB),
        "norm_c": gain(ks[10], (N_ODD, D_MODEL)),
        "w_in_c": dense(ks[11], (N_ODD, D_MODEL, IN_C), D_MODEL),
        "conv_w": dense(ks[12], (N_ODD, CONV_WIDTH, GDN_CONV_CH), CONV_WIDTH),
        "a_log": jnp.log(jax.random.uniform(ks[13], (N_ODD, GDN_HEADS), f32, 1.0, 16.0)),
        "dt_bias": dt + jnp.log(-jnp.expm1(-dt)),
        "o_norm": gain(ks[14], (N_ODD, GDN_DV)),
        "w_out_c": dense(ks[15], (N_ODD, GDN_VW, D_MODEL), GDN_VW),
        "final_norm": gain(ks[17], (D_MODEL,)),
    }


def reference(x, positions, norm_ab, w_in_ab, q_a_norm, w_q_b, kv_a_norm, w_kv_b, pool_w, pool_scale,
              w_out_ab, norm_c, w_in_c, conv_w, a_log, dt_bias, o_norm, w_out_c, final_norm):
    h = x
    for layer in range(DEPTH):
        i = layer // 2
        if layer % 2 == 0:
            h = h + mla_pool_layer(rmsnorm(h, norm_ab[i]), positions, w_in_ab[i], q_a_norm[i], w_q_b[i],
                                   kv_a_norm[i], w_kv_b[i], pool_w[i], pool_scale[i], w_out_ab[i])
        else:
            h = h + gdn_layer(rmsnorm(h, norm_c[i]), w_in_c[i], conv_w[i], a_log[i], dt_bias[i],
                              o_norm[i], w_out_c[i])
    return rmsnorm(h, final_norm)
```

```cpp
#include <hip/hip_runtime.h>
#include <hip/hip_cooperative_groups.h>
#include <cstdio>
#include <cstdint>
#include <cmath>
namespace cg = cooperative_groups;
namespace pg8 {
#define PG8_LAS __attribute__((address_space(3)))
typedef unsigned short bf16_t;
typedef short bf16x8 __attribute__((ext_vector_type(8)));
typedef float f32x4 __attribute__((ext_vector_type(4)));
typedef unsigned u32x4 __attribute__((ext_vector_type(4)));
constexpr int BM = 256, BK = 64, HALF = 128, HTB = HALF * BK * 2  , STAGE_BYTES = 8 * HTB, NXCD = 8, WGM = 8;

__host__ __device__ __forceinline__ int lds_byte(int r, int c) { const int st = (r >> 4) * 2 + (c >> 5), rr = r & 15, cc = c & 31, ob = rr * 64 + cc * 2; return st * 1024 + (ob ^ (((ob >> 9) & 1) << 5)); }
__host__ __device__ __forceinline__ void stage_rc(int b, int& R, int& C) { const int st = b / 1024, sb = b % 1024, swz = sb ^ (((sb >> 9) & 1) << 5); R = (st >> 1) * 16 + swz / 64; C = (st & 1) * 32 + (swz % 64) / 2; }
__host__ __device__ __forceinline__ int perm32(int rho) { const int n = rho >> 4, i = rho & 15; return 8 * (i >> 2) + 4 * n + (i & 3); }

struct Unit { int pm, pn; };
struct Gemm { const bf16_t* A; const bf16_t* Bt; int M, N, K; };

struct StaticOrder {
    int nM, nN, nwg, G, c;
    __host__ __device__ void init(int M, int N, int G_, int c_) { nM = M / BM; nN = N / BM; nwg = nM * nN; G = G_; c = c_; }
    __host__ __device__ bool next(int i, Unit& u) const {
        const long L = (long)i * G + c; if (L >= nwg) return false;
        int wgid = (int)L; { const int q = nwg / NXCD, r = nwg % NXCD, xcd = wgid % NXCD, off = wgid / NXCD; wgid = (xcd < r ? xcd * (q + 1) : r * (q + 1) + (xcd - r) * q) + off; }
        const int nig = WGM * nN, gid = wgid / nig, fm = gid * WGM, gsz = (nM - fm) < WGM ? (nM - fm) : WGM;
        u.pm = fm + ((wgid % nig) % gsz); u.pn = (wgid % nig) / gsz; return true;
    }
    __device__ __forceinline__ void a_ready(const Unit&) const {}
    __device__ __forceinline__ void done(const Unit&) const {}
};

__device__ __forceinline__ unsigned cvt_pk_bf16(float lo, float hi) { unsigned r; asm volatile("v_cvt_pk_bf16_f32 %0, %1, %2" : "=v"(r) : "v"(lo), "v"(hi)); return r; }

__device__ __forceinline__ unsigned lane_xpose(unsigned v, int src4) { return (unsigned)__builtin_amdgcn_ds_bpermute(src4, (int)v); }
__device__ __forceinline__ float lane_xposef(float v, int src4) { return __builtin_bit_cast(float, __builtin_amdgcn_ds_bpermute(src4, __builtin_bit_cast(int, v))); }
struct EpiB {
    static constexpr bool PERM = true, AFTER_DRAIN = false;
    bf16_t* O; int ldc; int split_cols; size_t split_stride;
    __device__ __forceinline__ void operator()(const f32x4 (&acc)[2][2][4][2], const Unit& u, int wr, int wc, int fr, int fq) const {
        const int L = fq * 16 + fr, Lr = L >> 2, Lq = L & 3, src4 = (16 * Lq + Lr) * 4;
        const int row0 = u.pm * BM + wr * 64 + Lr; int colt = u.pn * BM; bf16_t* base = O;
        if (split_cols) { const int t = colt / split_cols; base += (size_t)t * split_stride; colt -= t * split_cols; }
        const int col0 = colt + wc * 32 + 8 * Lq;
#pragma unroll
        for (int ai = 0; ai < 2; ++ai)
#pragma unroll
            for (int m = 0; m < 4; ++m) { bf16_t* rowp = base + (size_t)(row0 + ai * HALF + m * 16) * ldc + col0;
#pragma unroll
                for (int bj = 0; bj < 2; ++bj) { const f32x4 v0 = acc[ai][bj][m][0], v1 = acc[ai][bj][m][1];
                    u32x4 w; w.x = lane_xpose(cvt_pk_bf16(v0[0], v0[1]), src4); w.y = lane_xpose(cvt_pk_bf16(v0[2], v0[3]), src4); w.z = lane_xpose(cvt_pk_bf16(v1[0], v1[1]), src4); w.w = lane_xpose(cvt_pk_bf16(v1[2], v1[3]), src4);
                    *(u32x4*)(rowp + bj * HALF) = w; } }
    }
};
struct EpiRes {
    static constexpr bool PERM = true, AFTER_DRAIN = false;
    const float* R; float* O; int ldc;
    __device__ __forceinline__ void operator()(const f32x4 (&acc)[2][2][4][2], const Unit& u, int wr, int wc, int fr, int fq) const {
        const int L = fq * 16 + fr, Lr = L >> 2, Lq = L & 3, src4 = (16 * Lq + Lr) * 4;
        const int row0 = u.pm * BM + wr * 64 + Lr; const int col0 = u.pn * BM + wc * 32 + 8 * Lq;
#pragma unroll
        for (int ai = 0; ai < 2; ++ai)
#pragma unroll
            for (int m = 0; m < 4; ++m) { const size_t ro = (size_t)(row0 + ai * HALF + m * 16) * ldc + col0;
#pragma unroll
                for (int bj = 0; bj < 2; ++bj) { const size_t o = ro + bj * HALF;
                    const f32x4 r0 = *(const f32x4*)(R + o), r1 = *(const f32x4*)(R + o + 4);
                    const f32x4 s0 = acc[ai][bj][m][0], s1 = acc[ai][bj][m][1];
                    f32x4 a0, a1;
                    a0.x = lane_xposef(s0.x, src4); a0.y = lane_xposef(s0.y, src4); a0.z = lane_xposef(s0.z, src4); a0.w = lane_xposef(s0.w, src4);
                    a1.x = lane_xposef(s1.x, src4); a1.y = lane_xposef(s1.y, src4); a1.z = lane_xposef(s1.z, src4); a1.w = lane_xposef(s1.w, src4);
                    *(f32x4*)(O + o) = r0 + a0; *(f32x4*)(O + o + 4) = r1 + a1; } }
    }
};
struct EpiGate {
    static constexpr bool PERM = true, AFTER_DRAIN = false;
    bf16_t* O; int ldc; const bf16_t* Z; int ldz; const float* PS;
    __device__ __forceinline__ void operator()(const f32x4 (&acc)[2][2][4][2], const Unit& u, int wr, int wc, int fr, int fq) const {
        const int L = fq * 16 + fr, Lr = L >> 2, Lq = L & 3, src4 = (16 * Lq + Lr) * 4;
        const int row0 = u.pm * BM + wr * 64 + Lr; const int col0 = u.pn * BM + wc * 32 + 8 * Lq;
#pragma unroll
        for (int ai = 0; ai < 2; ++ai)
#pragma unroll
            for (int m = 0; m < 4; ++m) { const size_t row = (size_t)(row0 + ai * HALF + m * 16);
#pragma unroll
                for (int bj = 0; bj < 2; ++bj) { const int col = col0 + bj * HALF;
                    const f32x4 s0 = acc[ai][bj][m][0], s1 = acc[ai][bj][m][1];
                    const float a0 = lane_xposef(s0.x, src4), a1 = lane_xposef(s0.y, src4), a2 = lane_xposef(s0.z, src4), a3 = lane_xposef(s0.w, src4);
                    const float a4 = lane_xposef(s1.x, src4), a5 = lane_xposef(s1.y, src4), a6 = lane_xposef(s1.z, src4), a7 = lane_xposef(s1.w, src4);
                    const u32x4 z = *(const u32x4*)(Z + row * ldz + col); const f32x4 p0 = *(const f32x4*)(PS + col), p1 = *(const f32x4*)(PS + col + 4);
                    const float z0 = __builtin_bit_cast(float, z.x << 16), z1 = __builtin_bit_cast(float, z.x & 0xffff0000u), z2 = __builtin_bit_cast(float, z.y << 16), z3 = __builtin_bit_cast(float, z.y & 0xffff0000u);
                    const float z4 = __builtin_bit_cast(float, z.z << 16), z5 = __builtin_bit_cast(float, z.z & 0xffff0000u), z6 = __builtin_bit_cast(float, z.w << 16), z7 = __builtin_bit_cast(float, z.w & 0xffff0000u);
#define PG8_SILU(x) ((x) * __builtin_amdgcn_rcpf(1.f + __expf(-(x))))
                    u32x4 w; w.x = cvt_pk_bf16(a0 * p0.x * PG8_SILU(z0), a1 * p0.y * PG8_SILU(z1)); w.y = cvt_pk_bf16(a2 * p0.z * PG8_SILU(z2), a3 * p0.w * PG8_SILU(z3));
                    w.z = cvt_pk_bf16(a4 * p1.x * PG8_SILU(z4), a5 * p1.y * PG8_SILU(z5)); w.w = cvt_pk_bf16(a6 * p1.z * PG8_SILU(z6), a7 * p1.w * PG8_SILU(z7));
#undef PG8_SILU
                    *(u32x4*)(O + row * ldc + col) = w; } }
    }
};
template <class Epi, class Sched, bool ALIGN_EPI = false, bool SP2 = false>
__device__ __forceinline__ void gemm_phase(PG8_LAS unsigned char* lds, const Gemm g, const Sched& S, const Epi& E) {
    const int tid = threadIdx.x, wid = __builtin_amdgcn_readfirstlane(tid >> 6), lane = tid & 63, wr = wid >> 2, wc = wid & 3, fr = lane & 15, fq = lane >> 4;
    const int K = g.K, nt = K / BK;
    unsigned voffA[2], voffB[2];
#pragma unroll
    for (int i = 0; i < 2; ++i) { int R, C; stage_rc(tid * 16 + i * 8192, R, C); const int Rb = Epi::PERM ? ((R & ~31) + perm32(R & 31)) : R;
        voffA[i] = (unsigned)(R * K + C) * 2u; voffB[i] = (unsigned)(Rb * K + C) * 2u; }
    const size_t kstep = (size_t)(BK * 2);
    const size_t hstep = (size_t)HALF * K * 2;
    const size_t tstep = 2 * hstep;
    const unsigned ldsw = (unsigned)wid * 1024u;
    const int aoff = lds_byte(wr * 64 + fr, fq * 8), boff = lds_byte(wc * 32 + fr, fq * 8);
#define PG8_SA(b, h) (((b) * 2 + (h)) * HTB)
#define PG8_SB(b, h) ((4 + (b) * 2 + (h)) * HTB)
#define PG8_STAGE(bufoff, gbase, voff) do { _Pragma("unroll") for (int _i = 0; _i < 2; ++_i) \
        __builtin_amdgcn_global_load_lds((const unsigned*)((const char*)(gbase) + (voff)[_i]), (PG8_LAS unsigned*)(lds + (bufoff) + ldsw + _i * 8192), 16, 0, 0); } while (0)
#define PG8_LDA(dst, b, h) do { _Pragma("unroll") for (int m = 0; m < 4; ++m) _Pragma("unroll") for (int k = 0; k < 2; ++k) dst[m][k] = *(const PG8_LAS bf16x8*)(lds + PG8_SA(b, h) + aoff + m * 2048 + k * 1024); } while (0)
#define PG8_LDB(dst, b, h) do { _Pragma("unroll") for (int n = 0; n < 2; ++n) _Pragma("unroll") for (int k = 0; k < 2; ++k) dst[n][k] = *(const PG8_LAS bf16x8*)(lds + PG8_SB(b, h) + boff + n * 2048 + k * 1024); } while (0)
#define PG8_MMA(ai, bj, At, Bt) do { __builtin_amdgcn_s_setprio(1); _Pragma("unroll") for (int m = 0; m < 4; ++m) _Pragma("unroll") for (int n = 0; n < 2; ++n) _Pragma("unroll") for (int k = 0; k < 2; ++k) \
        acc[ai][bj][m][n] = __builtin_amdgcn_mfma_f32_16x16x32_bf16(Bt[n][k], At[m][k], acc[ai][bj][m][n], 0, 0, 0); __builtin_amdgcn_s_setprio(0); } while (0)
#define PG8_WAIT_V(n) asm volatile("s_waitcnt vmcnt(" #n ")" ::: "memory")
#define PG8_WAIT_L(n) asm volatile("s_waitcnt lgkmcnt(" #n ")" ::: "memory")
#define PG8_BAR __builtin_amdgcn_s_barrier()
#define PG8_SCHED __builtin_amdgcn_sched_barrier(0)
    Unit cur, nxt; int ui = 0;
    if (!S.next(0, cur)) return;
    f32x4 acc[2][2][4][2];
#pragma unroll
    for (int a = 0; a < 2; ++a)
#pragma unroll
        for (int b = 0; b < 2; ++b)
#pragma unroll
            for (int m = 0; m < 4; ++m)
#pragma unroll
                for (int n = 0; n < 2; ++n) acc[a][b][m][n] = (f32x4){0.f, 0.f, 0.f, 0.f};
    bf16x8 At[4][2], B0[2][2], B1[2][2];
    const char* cA = (const char*)g.A + (size_t)cur.pm * tstep; const char* cB = (const char*)g.Bt + (size_t)cur.pn * tstep;
    S.a_ready(cur);
    if constexpr (SP2) {
        PG8_STAGE(PG8_SB(0, 0), cB, voffB); PG8_STAGE(PG8_SB(0, 1), cB + hstep, voffB); PG8_STAGE(PG8_SA(0, 0), cA, voffA); PG8_STAGE(PG8_SA(0, 1), cA + hstep, voffA);
        if (wr == 1) PG8_BAR;
        PG8_WAIT_V(2); PG8_BAR;
        PG8_STAGE(PG8_SB(1, 0), cB + kstep, voffB); PG8_STAGE(PG8_SA(1, 0), cA + kstep, voffA); PG8_STAGE(PG8_SB(1, 1), cB + hstep + kstep, voffB);
        PG8_WAIT_V(6); PG8_BAR;
    } else {
        PG8_STAGE(PG8_SB(0, 0), cB, voffB); PG8_STAGE(PG8_SA(0, 0), cA, voffA); PG8_STAGE(PG8_SB(0, 1), cB + hstep, voffB); PG8_STAGE(PG8_SA(0, 1), cA + hstep, voffA);
        if (wr == 1) PG8_BAR;
        PG8_WAIT_V(4); PG8_BAR;
        PG8_STAGE(PG8_SB(1, 0), cB + kstep, voffB); PG8_STAGE(PG8_SA(1, 0), cA + kstep, voffA); PG8_STAGE(PG8_SB(1, 1), cB + hstep + kstep, voffB);
        PG8_WAIT_V(6); PG8_BAR;
    }
    for (;;) {
        const bool has_next = S.next(ui + 1, nxt);
        const char* nA = has_next ? (const char*)g.A + (size_t)nxt.pm * tstep : cA; const char* nB = has_next ? (const char*)g.Bt + (size_t)nxt.pn * tstep : cB;
        for (int t = 0; t < nt; t += 2) {
            const bool last = (t == nt - 2);
            const char* a1 = cA + (size_t)(t + 1) * kstep;
            const char* a2 = last ? nA : cA + (size_t)(t + 2) * kstep; const char* b2 = last ? nB : cB + (size_t)(t + 2) * kstep;
            const char* a3 = a2 + kstep; const char* b3 = b2 + kstep;
            if (last && has_next) S.a_ready(nxt);
            if constexpr (SP2) {
            PG8_LDB(B0, 0, 0); PG8_LDB(B1, 0, 1); PG8_SCHED; PG8_LDA(At, 0, 0); PG8_STAGE(PG8_SA(1, 1), a1 + hstep, voffA);
            PG8_WAIT_V(8); PG8_WAIT_L(0); PG8_BAR; PG8_MMA(0, 0, At, B0); PG8_MMA(0, 1, At, B1); PG8_BAR; PG8_SCHED;
            PG8_LDA(At, 0, 1); PG8_STAGE(PG8_SB(0, 0), b2, voffB); PG8_STAGE(PG8_SB(0, 1), b2 + hstep, voffB); PG8_STAGE(PG8_SA(0, 0), a2, voffA);
            PG8_WAIT_V(8); PG8_WAIT_L(0); PG8_BAR; PG8_MMA(1, 0, At, B0); PG8_MMA(1, 1, At, B1); PG8_BAR; PG8_SCHED;
            PG8_LDB(B0, 1, 0); PG8_LDB(B1, 1, 1); PG8_SCHED; PG8_LDA(At, 1, 0); PG8_STAGE(PG8_SA(0, 1), a2 + hstep, voffA);
            PG8_WAIT_V(8); PG8_WAIT_L(0); PG8_BAR; PG8_MMA(0, 0, At, B0); PG8_MMA(0, 1, At, B1); PG8_BAR; PG8_SCHED;
            PG8_LDA(At, 1, 1); PG8_STAGE(PG8_SB(1, 0), b3, voffB); PG8_STAGE(PG8_SB(1, 1), b3 + hstep, voffB); PG8_STAGE(PG8_SA(1, 0), a3, voffA);
            PG8_WAIT_V(8); PG8_WAIT_L(0); PG8_BAR; PG8_MMA(1, 0, At, B0); PG8_MMA(1, 1, At, B1); PG8_BAR; PG8_SCHED;
            } else {
            PG8_LDB(B0, 0, 0); PG8_SCHED; PG8_LDA(At, 0, 0); PG8_STAGE(PG8_SA(1, 1), a1 + hstep, voffA);
            PG8_WAIT_L(8); PG8_BAR; PG8_WAIT_L(0); PG8_MMA(0, 0, At, B0); PG8_BAR; PG8_SCHED;
            PG8_LDB(B1, 0, 1); PG8_STAGE(PG8_SB(0, 0), b2, voffB);
            PG8_BAR; PG8_WAIT_L(0); PG8_MMA(0, 1, At, B1); PG8_BAR;
            PG8_LDA(At, 0, 1); PG8_STAGE(PG8_SA(0, 0), a2, voffA);
            PG8_BAR; PG8_WAIT_L(0); PG8_MMA(1, 0, At, B0); PG8_BAR; PG8_SCHED;
            PG8_STAGE(PG8_SB(0, 1), b2 + hstep, voffB);
            PG8_WAIT_V(6); PG8_BAR; PG8_MMA(1, 1, At, B1); PG8_BAR;
            PG8_LDB(B0, 1, 0); PG8_SCHED; PG8_LDA(At, 1, 0); PG8_STAGE(PG8_SA(0, 1), a2 + hstep, voffA);
            PG8_WAIT_L(8); PG8_BAR; PG8_WAIT_L(0); PG8_MMA(0, 0, At, B0); PG8_BAR; PG8_SCHED;
            PG8_LDB(B1, 1, 1); PG8_STAGE(PG8_SB(1, 0), b3, voffB);
            PG8_BAR; PG8_WAIT_L(0); PG8_MMA(0, 1, At, B1); PG8_BAR;
            PG8_LDA(At, 1, 1); PG8_STAGE(PG8_SA(1, 0), a3, voffA);
            PG8_BAR; PG8_WAIT_L(0); PG8_MMA(1, 0, At, B0); PG8_BAR; PG8_SCHED;
            PG8_STAGE(PG8_SB(1, 1), b3 + hstep, voffB);
            PG8_WAIT_V(6); PG8_BAR; PG8_MMA(1, 1, At, B1); PG8_BAR;
            }
        }
        if constexpr (ALIGN_EPI) { if (wr == 0) PG8_BAR; }
        if constexpr (!Epi::AFTER_DRAIN) { E(acc, cur, wr, wc, fr, fq); S.done(cur); }
        if (!has_next) break;
#pragma unroll
        for (int a = 0; a < 2; ++a)
#pragma unroll
            for (int b = 0; b < 2; ++b)
#pragma unroll
                for (int m = 0; m < 4; ++m)
#pragma unroll
                    for (int n = 0; n < 2; ++n) acc[a][b][m][n] = (f32x4){0.f, 0.f, 0.f, 0.f};
        cur = nxt; cA = nA; cB = nB; ++ui;
        if constexpr (ALIGN_EPI) { if (wr == 1) PG8_BAR; }
    }
    PG8_WAIT_V(0);
    if constexpr (!ALIGN_EPI) { if (wr == 0) PG8_BAR; }
    PG8_BAR;
    if constexpr (Epi::AFTER_DRAIN) { E.fused(acc, cur, wr, wc, fr, fq, lds, wid, lane); S.done(cur); }
#undef PG8_SA
#undef PG8_SB
#undef PG8_STAGE
#undef PG8_LDA
#undef PG8_LDB
#undef PG8_MMA
#undef PG8_WAIT_V
#undef PG8_WAIT_L
#undef PG8_BAR
#undef PG8_SCHED
}
}

#define LAS __attribute__((address_space(3)))
typedef unsigned short bf16;
typedef unsigned v4u __attribute__((ext_vector_type(4)));
typedef unsigned v2u __attribute__((ext_vector_type(2)));
typedef float f32x4 __attribute__((ext_vector_type(4)));
typedef float f32x16 __attribute__((ext_vector_type(16)));
typedef short bf16x8 __attribute__((ext_vector_type(8)));
typedef short s16x4 __attribute__((ext_vector_type(4)));
#define LDS_WAIT() asm volatile("s_waitcnt lgkmcnt(0)" ::: "memory")

constexpr int T_ = 32768, S_ = 8192, D_ = 1024, NW = 8, NTHR = 512;
constexpr size_t MiB = 1u << 20, REG = 64 * MiB;
constexpr size_t RGN(int i) { return (size_t)i * REG; }
constexpr size_t MISC = 7 * REG;
constexpr size_t O_WIN0 = MISC + 0 * MiB, O_WQKV = MISC + 4 * MiB, O_WPOOL = MISC + 6 * MiB, O_WOUTAB = MISC + 7 * MiB, O_WINC = MISC + 9 * MiB, O_WOUTC = MISC + 17 * MiB,
                 O_ROPE = MISC + 19 * MiB, O_G = MISC + 23 * MiB, O_BETA = MISC + 24 * MiB, O_GL = MISC + 25 * MiB, O_BAR = MISC + 26 * MiB, WS_NEED = MISC + 27 * MiB;
constexpr int LDS_BYTES = 147456;
constexpr int P0LD = 2176;
constexpr size_t O_QKV = 3 * REG + 16 * MiB;
constexpr float EPS = 1e-6f;

__device__ __forceinline__ float bflo(unsigned u) { return __builtin_bit_cast(float, u << 16); }
__device__ __forceinline__ float bfhi(unsigned u) { return __builtin_bit_cast(float, u & 0xffff0000u); }
__device__ __forceinline__ float bf1(bf16 b) { return __builtin_bit_cast(float, (unsigned)b << 16); }
__device__ __forceinline__ unsigned f2bf(float f) { unsigned u = __builtin_bit_cast(unsigned, f); return (u + 0x7fffu + ((u >> 16) & 1u)) >> 16; }
typedef __bf16 hwbf16x2 __attribute__((ext_vector_type(2)));
typedef float f32x2v __attribute__((ext_vector_type(2)));
__device__ __forceinline__ unsigned pk2(float lo, float hi) { const f32x2v v = {lo, hi}; return __builtin_bit_cast(unsigned, __builtin_convertvector(v, hwbf16x2)); }
__device__ __forceinline__ float row16_sum(float v) {
    v += __builtin_bit_cast(float, __builtin_amdgcn_update_dpp(0, __builtin_bit_cast(int, v), 0x128, 0xf, 0xf, false));
    v += __builtin_bit_cast(float, __builtin_amdgcn_update_dpp(0, __builtin_bit_cast(int, v), 0x124, 0xf, 0xf, false));
    v += __builtin_bit_cast(float, __builtin_amdgcn_update_dpp(0, __builtin_bit_cast(int, v), 0x122, 0xf, 0xf, false));
    v += __builtin_bit_cast(float, __builtin_amdgcn_update_dpp(0, __builtin_bit_cast(int, v), 0x121, 0xf, 0xf, false));
    return v;
}
__device__ __forceinline__ float wave_sum(float v) { v = row16_sum(v); v += __shfl_xor(v, 16); v += __shfl_xor(v, 32); return v; }
__device__ __forceinline__ float silu(float z) { return z * __builtin_amdgcn_rcpf(1.f + __expf(-z)); }


struct Args { const void* in[19]; float* out; unsigned char* ws; float inv_freq[16]; int ph_lo, ph_hi, dry, pad; };

__device__ __forceinline__ void transpose_item(const float* W, int ldw, bf16* WT, int ldt, int k0, int n0, int trow0, int tcol0, LAS float* scr, int lane) {
#pragma unroll 8
    for (int i = 0; i < 32; ++i) { const int kk = 2 * i + (lane >> 5); scr[kk * 33 + (lane & 31)] = W[(size_t)(k0 + kk) * ldw + n0 + (lane & 31)]; }
    LDS_WAIT();
    const int c = lane & 7;
#pragma unroll
    for (int j = 0; j < 4; ++j) { const int n = (lane >> 3) + 8 * j; const LAS float* s = scr + (8 * c) * 33 + n;
        v4u o; o.x = pk2(s[0 * 33], s[1 * 33]); o.y = pk2(s[2 * 33], s[3 * 33]); o.z = pk2(s[4 * 33], s[5 * 33]); o.w = pk2(s[6 * 33], s[7 * 33]);
        *(v4u*)(WT + (size_t)(trow0 + n) * ldt + tcol0 + 8 * c) = o; }
    LDS_WAIT();
}
__device__ __forceinline__ void transpose_job(const float* W, int ldw, int Nuse, bf16* WT, int ldt, int n_off, int k_off, int item, LAS float* scr, int lane) {
    const int nblk = Nuse / 32, kb = item / nblk, nb = item % nblk;
    transpose_item(W, ldw, WT, ldt, 64 * kb, 32 * nb, n_off + 32 * nb, k_off + 64 * kb, scr, lane);
}

__device__ __forceinline__ void p0_prologue(const Args& a, LAS unsigned char* lds) {
    const int tid = threadIdx.x, lane = tid & 63, wave = tid >> 6;
    const int gw = blockIdx.x * NW + wave, NGW = gridDim.x * NW;
    unsigned char* ws = a.ws;
    LAS float* scr = (LAS float*)(lds + wave * 16384);
    bf16* WIN0 = (bf16*)(ws + O_WIN0); bf16* WQKV = (bf16*)(ws + O_WQKV); bf16* WPOOL = (bf16*)(ws + O_WPOOL); bf16* WOUTAB = (bf16*)(ws + O_WOUTAB);
    bf16* WINC = (bf16*)(ws + O_WINC); bf16* WOUTC = (bf16*)(ws + O_WOUTC);
    constexpr int I0 = 16 * 61, I1 = 4 * 24, I2 = 2 * 32, I3 = 4 * 8, I4 = 16 * 32, I5 = 16 * 128, I6 = 16 * 32, NIT = I0 + I1 + I2 + I3 + I4 + I5 + I6;
    for (int it = gw; it < NIT; it += NGW) {
        int r = it;
        if (r < I0) { transpose_job((const float*)a.in[3], 1952, 1952, WIN0, 1024, 0, 0, r, scr, lane); continue; } r -= I0;
        if (r < I1) { transpose_job((const float*)a.in[5], 768, 768, WQKV, 384, 0, 0, r, scr, lane); continue; } r -= I1;
        if (r < I2) { transpose_job((const float*)a.in[7], 1024, 1024, WQKV, 384, 768, 256, r, scr, lane); continue; } r -= I2;
        if (r < I3) { const int g = r >> 3; transpose_job((const float*)a.in[8] + (size_t)g * 128 * 128, 128, 128, WPOOL, 512, g * 128, g * 128, r & 7, scr, lane); continue; } r -= I3;
        if (r < I4) { transpose_job((const float*)a.in[10], 1024, 1024, WOUTAB, 1024, 0, 0, r, scr, lane); continue; } r -= I4;
        if (r < I5) { transpose_job((const float*)a.in[12], 4112, 4096, WINC, 1024, 0, 0, r, scr, lane); continue; } r -= I5;
        transpose_job((const float*)a.in[17], 1024, 1024, WOUTC, 1024, 0, 0, r, scr, lane);
    }
    const int gt = blockIdx.x * NTHR + tid, NGT = gridDim.x * NTHR;
    const v4u z4 = {0u, 0u, 0u, 0u};
    for (int i = gt; i < 96 * 128; i += NGT) *(v4u*)(WIN0 + (size_t)1952 * 1024 + (size_t)i * 8) = z4;
    for (int i = gt; i < 1792 * 48; i += NGT) { const int row = i / 48, c8 = (i % 48) * 8; const bool isq = row < 768; const bool zero = isq ? (c8 >= 256) : (c8 < 256); if (zero) *(v4u*)(WQKV + (size_t)row * 384 + c8) = z4; }
    for (int i = gt; i < 512 * 64; i += NGT) { const int row = i / 64, c8 = (i % 64) * 8; if ((row >> 7) != (c8 >> 7)) *(v4u*)(WPOOL + (size_t)row * 512 + c8) = z4; }
    { float2* rope = (float2*)(ws + O_ROPE); const int* pos = (const int*)a.in[1];
      for (int i = gt; i < T_ * 16; i += NGT) { const int t = i >> 4, f = i & 15; const float ang = (float)pos[t] * a.inv_freq[f];
          const float C_HI = 0.15915494f, C_LO = 3.0908620e-9f;
          const float rev = ang * C_HI; const float err = fmaf(ang, C_HI, -rev) + ang * C_LO; const float fr = (rev - rintf(rev)) + err;
          rope[i] = make_float2(__builtin_amdgcn_cosf(fr), __builtin_amdgcn_sinf(fr)); } }
    { const float* x = (const float*)a.in[0]; const float* g = (const float*)a.in[2]; bf16* XN = (bf16*)(ws + RGN(0));
      f32x4 gv[4];
#pragma unroll
      for (int j = 0; j < 4; ++j) gv[j] = *(const f32x4*)(g + 4 * lane + 256 * j);
      f32x4 nv[4];
      { const f32x4* xr = (const f32x4*)(x + (size_t)(gw < T_ ? gw : 0) * D_) + lane;
#pragma unroll
        for (int j = 0; j < 4; ++j) nv[j] = __builtin_nontemporal_load(xr + 64 * j); }
      for (int m = gw; m < T_; m += NGW) {
          f32x4 v[4]; float s = 0.f;
          { const int mn = (m + NGW < T_) ? m + NGW : m; const f32x4* xn = (const f32x4*)(x + (size_t)mn * D_) + lane;
#pragma unroll
            for (int j = 0; j < 4; ++j) { v[j] = nv[j]; nv[j] = __builtin_nontemporal_load(xn + 64 * j); } }
#pragma unroll
          for (int j = 0; j < 4; ++j) s += (v[j].x * v[j].x + v[j].y * v[j].y) + (v[j].z * v[j].z + v[j].w * v[j].w);
          const float rs = rsqrtf(wave_sum(s) * (1.f / D_) + EPS);
          v2u* o8 = (v2u*)(XN + (size_t)m * D_) + lane;
#pragma unroll
          for (int j = 0; j < 4; ++j) { v2u o; o.x = pk2(v[j].x * rs * gv[j].x, v[j].y * rs * gv[j].y); o.y = pk2(v[j].z * rs * gv[j].z, v[j].w * rs * gv[j].w); o8[64 * j] = o; }
      } }
}

__device__ __forceinline__ void p2_prep(const Args& a) {
    const int tid = threadIdx.x, lane = tid & 63, wave = tid >> 6;
    const int gw = blockIdx.x * NW + wave, NGW = gridDim.x * NW;
    unsigned char* ws = a.ws;
    const bf16* proj0 = (const bf16*)(ws + RGN(1));
    bf16* A2 = (bf16*)(ws + RGN(5)); bf16* KR = (bf16*)(ws + RGN(5) + 24 * MiB); bf16* DP = (bf16*)(ws + RGN(5) + 26 * MiB);
    const float2* rope = (const float2*)(ws + O_ROPE);
    const f32x4 qg = *(const f32x4*)((const float*)a.in[4] + 4 * lane);
    const float2 kg = *(const float2*)((const float*)a.in[6] + 2 * lane);
    for (int t = gw; t < T_; t += NGW) {
        const bf16* pr = proj0 + (size_t)t * P0LD;
        { const v2u q = __builtin_nontemporal_load((const v2u*)(pr + 4 * lane)); const float q0 = bflo(q.x), q1 = bfhi(q.x), q2 = bflo(q.y), q3 = bfhi(q.y);
          const float rs = rsqrtf(wave_sum((q0 * q0 + q1 * q1) + (q2 * q2 + q3 * q3)) * (1.f / 256.f) + EPS);
          v2u o; o.x = pk2(q0 * rs * qg.x, q1 * rs * qg.y); o.y = pk2(q2 * rs * qg.z, q3 * rs * qg.w); *(v2u*)(A2 + (size_t)t * 384 + 4 * lane) = o; }
        { const unsigned k = __builtin_nontemporal_load((const unsigned*)(pr + 256 + 2 * lane)); const float k0 = bflo(k), k1 = bfhi(k);
          const float rs = rsqrtf(wave_sum(k0 * k0 + k1 * k1) * (1.f / 128.f) + EPS);
          *(unsigned*)(A2 + (size_t)t * 384 + 256 + 2 * lane) = pk2(k0 * rs * kg.x, k1 * rs * kg.y); }
        if (lane < 16) { const float x1 = bf1(pr[384 + lane]), x2 = bf1(pr[400 + lane]); const float2 cs = rope[(size_t)t * 16 + lane];
          *(unsigned*)(KR + (size_t)t * 32 + 2 * lane) = pk2(x1 * cs.x - x2 * cs.y, x2 * cs.x + x1 * cs.y); }
        { const int g = lane >> 4, w = 2 << g, ts = t & (S_ - 1), cnt = min(ts + 1, w);
          float acc[8];
#pragma unroll
          for (int e = 0; e < 8; ++e) acc[e] = 0.f;
          v4u wv[16];
#pragma unroll
          for (int j = 0; j < 16; ++j) { const int jj = (j < cnt) ? j : 0; wv[j] = *(const v4u*)(pr - (size_t)jj * P0LD + 416 + 8 * lane); }
          float x0[8];
#pragma unroll
          for (int j = 0; j < 16; ++j) { const v4u v = wv[j]; const float mk = (j < cnt) ? 1.f : 0.f;
              const float f[8] = {bflo(v.x), bfhi(v.x), bflo(v.y), bfhi(v.y), bflo(v.z), bfhi(v.z), bflo(v.w), bfhi(v.w)};
#pragma unroll
              for (int e = 0; e < 8; ++e) { acc[e] = fmaf(f[e], mk, acc[e]); if (j == 0) x0[e] = f[e]; }
          }
          const float ic = 1.f / (float)cnt; v4u o;
          o.x = pk2(acc[0] * ic - x0[0], acc[1] * ic - x0[1]); o.y = pk2(acc[2] * ic - x0[2], acc[3] * ic - x0[3]);
          o.z = pk2(acc[4] * ic - x0[4], acc[5] * ic - x0[5]); o.w = pk2(acc[6] * ic - x0[6], acc[7] * ic - x0[7]);
          *(v4u*)(DP + (size_t)t * 512 + 8 * lane) = o; }
    }
}

constexpr int KROW = 208, KBYTES = 64 * KROW, VBYTES = 8192;
typedef short v4i16_t __attribute__((ext_vector_type(4)));
__device__ __forceinline__ s16x4 vtr(const LAS unsigned char* p) { return __builtin_bit_cast(s16x4, __builtin_amdgcn_ds_read_tr16_b64_v4i16((LAS v4i16_t*)p)); }
__device__ __forceinline__ bf16x8 cat8(s16x4 lo, s16x4 hi) { bf16x8 r; r[0] = lo[0]; r[1] = lo[1]; r[2] = lo[2]; r[3] = lo[3]; r[4] = hi[0]; r[5] = hi[1]; r[6] = hi[2]; r[7] = hi[3]; return r; }
__device__ __forceinline__ bf16x8 pack8(float a0, float a1, float a2, float a3, float a4, float a5, float a6, float a7) {
    v4u u; u.x = pk2(a0, a1); u.y = pk2(a2, a3); u.z = pk2(a4, a5); u.w = pk2(a6, a7); return __builtin_bit_cast(bf16x8, u); }

__device__ __forceinline__ void attn_unit(LAS unsigned char* lds, int b, int h, int qb, const bf16* qkv, const bf16* KR, const float2* rope, const bf16* proj0, bf16* Y) {
    int tid = threadIdx.x; asm volatile("" : "+v"(tid));
    const int lane = tid & 63, wave = __builtin_amdgcn_readfirstlane(tid >> 6), r = lane & 31, hh = lane >> 5;
    const int q0 = qb * 256, myq = q0 + 32 * wave + r;
    const size_t tq = (size_t)b * S_ + myq;
    const float CS = 0.10206207261596577f * 1.4426950408889634f;
    bf16x8 Qf[6];
    { const bf16* qp = qkv + tq * 1792 + h * 96;
#pragma unroll
      for (int s = 0; s < 4; ++s) Qf[s] = *(const bf16x8*)(qp + 16 * s + 8 * hh);
#pragma unroll
      for (int s2 = 0; s2 < 2; ++s2) { const int i0 = 8 * s2 + 4 * hh;
          const v2u xa = *(const v2u*)(qp + 64 + i0), xb = *(const v2u*)(qp + 80 + i0);
          const f32x4 c0 = *(const f32x4*)(rope + tq * 16 + i0), c1 = *(const f32x4*)(rope + tq * 16 + i0 + 2);
          const float a0 = bflo(xa.x), a1 = bfhi(xa.x), a2 = bflo(xa.y), a3 = bfhi(xa.y), b0 = bflo(xb.x), b1 = bfhi(xb.x), b2 = bflo(xb.y), b3 = bfhi(xb.y);
          Qf[4 + s2] = pack8(a0 * c0.x - b0 * c0.y, b0 * c0.x + a0 * c0.y, a1 * c0.z - b1 * c0.w, b1 * c0.z + a1 * c0.w,
                             a2 * c1.x - b2 * c1.y, b2 * c1.x + a2 * c1.y, a3 * c1.z - b3 * c1.w, b3 * c1.z + a3 * c1.w); } }
    const int skey = tid >> 3, sch = tid & 7, rkey = tid >> 2, rch = tid & 3;
    const bf16* kvbase = qkv + ((size_t)b * S_) * 1792 + 768 + h * 128;
    const bf16* krbase = KR + ((size_t)b * S_) * 32;
    constexpr int KB2 = 128 * KROW, VB2 = 2 * VBYTES, VOFF = 2 * KB2;
    const int NT = 2 * (qb + 1);
    const int qhi = q0 + 32 * wave + 31, qlo = q0 + 32 * wave;
    v4u gk0, gk1, gr, gv0, gv1;
#define ATT_LDK(T_) do { const size_t kk_ = (size_t)(T_) * 128; \
        gk0 = *(const v4u*)(kvbase + (kk_ + skey) * 1792 + sch * 8); gk1 = *(const v4u*)(kvbase + (kk_ + 64 + skey) * 1792 + sch * 8); \
        gr = *(const v4u*)(krbase + (kk_ + rkey) * 32 + rch * 8); } while (0)
#define ATT_LDV(T_) do { const size_t kk_ = (size_t)(T_) * 128; \
        gv0 = *(const v4u*)(kvbase + (kk_ + skey) * 1792 + 64 + sch * 8); gv1 = *(const v4u*)(kvbase + (kk_ + 64 + skey) * 1792 + 64 + sch * 8); } while (0)
#define ATT_LD(T_) do { ATT_LDK(T_); ATT_LDV(T_); } while (0)
#define ATT_STK(buf) do { LAS unsigned char* Kn_ = lds + (buf) * KB2; \
        *(LAS v4u*)(Kn_ + skey * KROW + sch * 16) = gk0; *(LAS v4u*)(Kn_ + (64 + skey) * KROW + sch * 16) = gk1; *(LAS v4u*)(Kn_ + rkey * KROW + 128 + rch * 16) = gr; } while (0)
#define ATT_STV(buf) do { LAS unsigned char* Vn_ = lds + VOFF + (buf) * VB2; \
        *(LAS v4u*)(Vn_ + (sch >> 2) * 4096 + skey * 64 + (sch & 3) * 16) = gv0; *(LAS v4u*)(Vn_ + VBYTES + (sch >> 2) * 4096 + skey * 64 + (sch & 3) * 16) = gv1; } while (0)
#define ATT_ST(buf) do { ATT_STK(buf); ATT_STV(buf); } while (0)
#define ATT_QK(dst0, dst1, Kb_) do { \
        _Pragma("unroll") for (int i_ = 0; i_ < 16; ++i_) { dst0[i_] = 0.f; dst1[i_] = 0.f; } \
        _Pragma("unroll") for (int s_ = 0; s_ < 6; ++s_) { \
            const bf16x8 ka_ = *(const LAS bf16x8*)((Kb_) + r * KROW + (16 * s_ + 8 * hh) * 2); const bf16x8 kb_ = *(const LAS bf16x8*)((Kb_) + (32 + r) * KROW + (16 * s_ + 8 * hh) * 2); \
            dst0 = __builtin_amdgcn_mfma_f32_32x32x16_bf16(ka_, Qf[s_], dst0, 0, 0, 0); dst1 = __builtin_amdgcn_mfma_f32_32x32x16_bf16(kb_, Qf[s_], dst1, 0, 0, 0); } } while (0)
#define ATT_SMPV(s0, s1, kbase_, Vb_, GEN, FIRST) do { \
        if (GEN) { \
            if ((kbase_) + 63 > qlo) { \
                _Pragma("unroll") for (int i = 0; i < 16; ++i) { const int key = (kbase_) + 8 * (i >> 2) + 4 * hh + (i & 3); \
                    if (key > myq) s0[i] = -INFINITY; if (key + 32 > myq) s1[i] = -INFINITY; } } \
            if (FIRST) { float mx = fmaxf(s0[0], s1[0]); \
                _Pragma("unroll") for (int i = 1; i < 16; ++i) mx = fmaxf(mx, fmaxf(s0[i], s1[i])); \
                m_run = fmaxf(mx, __shfl_xor(mx, 32)); } \
        } \
        const float nm = -m_run * CS; float ps = 0.f; \
        _Pragma("unroll") for (int i = 0; i < 16; ++i) { s0[i] = __builtin_amdgcn_exp2f(fmaf(s0[i], CS, nm)); s1[i] = __builtin_amdgcn_exp2f(fmaf(s1[i], CS, nm)); ps += s0[i] + s1[i]; } \
        l_run += ps; \
        const bf16x8 P00 = pack8(s0[0], s0[1], s0[2], s0[3], s0[4], s0[5], s0[6], s0[7]); \
        const bf16x8 P01 = pack8(s0[8], s0[9], s0[10], s0[11], s0[12], s0[13], s0[14], s0[15]); \
        const bf16x8 P10 = pack8(s1[0], s1[1], s1[2], s1[3], s1[4], s1[5], s1[6], s1[7]); \
        const bf16x8 P11 = pack8(s1[8], s1[9], s1[10], s1[11], s1[12], s1[13], s1[14], s1[15]); \
        _Pragma("unroll") for (int ks = 0; ks < 4; ++ks) { \
            const bf16x8 P = ks == 0 ? P00 : ks == 1 ? P01 : ks == 2 ? P10 : P11; \
            const LAS unsigned char* vp = (Vb_) + (16 * ks) * 64 + troff; \
            const bf16x8 va0 = cat8(vtr(vp), vtr(vp + 8 * 64)); \
            const bf16x8 va1 = cat8(vtr(vp + 4096), vtr(vp + 4096 + 8 * 64)); \
            o0 = __builtin_amdgcn_mfma_f32_32x32x16_bf16(va0, P, o0, 0, 0, 0); \
            o1 = __builtin_amdgcn_mfma_f32_32x32x16_bf16(va1, P, o1, 0, 0, 0); } } while (0)
#define ATT_ITER(GEN) do { \
        const int kb0 = T * 128; \
        const int Tn = T + 1 < NT ? T + 1 : T; ATT_LDK(Tn); \
        const LAS unsigned char* Kb = lds + (T & 1) * KB2; const LAS unsigned char* Vb = lds + VOFF + (T & 1) * VB2; \
        const bool actA = !(GEN) || (kb0 <= qhi), actB = !(GEN) || (kb0 + 64 <= qhi); \
        if (actA) ATT_QK(a0, a1, Kb); \
        if (actB) ATT_QK(b0, b1, Kb + 64 * KROW); \
        ATT_STK((T + 1) & 1); ATT_LDV(Tn); \
        if (actA) ATT_SMPV(a0, a1, kb0, Vb, GEN, T == 0); \
        if (actB) ATT_SMPV(b0, b1, kb0 + 64, Vb + VBYTES, GEN, false); \
        ATT_STV((T + 1) & 1); \
        __syncthreads(); } while (0)
    f32x16 o0, o1, a0, a1, b0, b1; float m_run = -INFINITY, l_run = 0.f;
#pragma unroll
    for (int i = 0; i < 16; ++i) { o0[i] = 0.f; o1[i] = 0.f; }
    const int g4 = lane >> 4, tq_ = (lane & 15) >> 2, tp = lane & 3;
    const int troff = (4 * hh + tq_) * 64 + (16 * (g4 & 1) + 4 * tp) * 2;
    ATT_LD(0); ATT_ST(0);
    __syncthreads();
    int T = 0;
    ATT_ITER(true);
    for (T = 1; T < 2 * qb; ++T) ATT_ITER(false);
    for (; T < NT; ++T) ATT_ITER(true);
#undef ATT_LD
#undef ATT_LDK
#undef ATT_LDV
#undef ATT_ST
#undef ATT_STK
#undef ATT_STV
#undef ATT_QK
#undef ATT_SMPV
#undef ATT_ITER
    const float lt = l_run + __shfl_xor(l_run, 32), inv = 1.f / lt;
    const bf16* zp = proj0 + tq * P0LD + 928 + h * 64; bf16* yp = Y + tq * 1024 + h * 64;
#pragma unroll
    for (int c = 0; c < 2; ++c)
#pragma unroll
        for (int gq = 0; gq < 4; ++gq) { const int dv = 32 * c + 8 * gq + 4 * hh;
            const v2u z = *(const v2u*)(zp + dv);
            const float v0 = (c ? o1[4 * gq + 0] : o0[4 * gq + 0]) * inv, v1 = (c ? o1[4 * gq + 1] : o0[4 * gq + 1]) * inv, v2 = (c ? o1[4 * gq + 2] : o0[4 * gq + 2]) * inv, v3 = (c ? o1[4 * gq + 3] : o0[4 * gq + 3]) * inv;
            v2u o; o.x = pk2(v0 * silu(bflo(z.x)), v1 * silu(bfhi(z.x))); o.y = pk2(v2 * silu(bflo(z.y)), v3 * silu(bfhi(z.y)));
            *(v2u*)(yp + dv) = o; }
}

__device__ __forceinline__ void p4_attn(const Args& a, LAS unsigned char* lds) {
    unsigned char* ws = a.ws;
    const bf16* proj0 = (const bf16*)(ws + RGN(1)); const bf16* qkv = (const bf16*)(ws + O_QKV); const bf16* KR = (const bf16*)(ws + RGN(5) + 24 * MiB);
    const bf16* YB = (const bf16*)(ws + RGN(6)); bf16* Y = (bf16*)(ws + RGN(0)); const float2* rope = (const float2*)(ws + O_ROPE);
    for (int it = blockIdx.x; it < 512; it += gridDim.x) {
        const int xcd = it & 7, j = it >> 3, bh = xcd * 4 + (j & 3), pr = j >> 2, b = bh >> 3, h = bh & 7;
#pragma unroll 1
        for (int u = 0; u < 2; ++u) attn_unit(lds, b, h, u ? 31 - pr : pr, qkv, KR, rope, proj0, Y);
    }
}

#define XB_TMO      128
#define XB_XCNT(j)  (256  + 64 * (j))
#define XB_XSUB(j)  (1280 + 64 * (j))
#define XB_XGEN(j)  (2304 + 64 * (j))
#define XB_TOP      3328
#define XB_TOPGEN   3392
#define XCD_BAR_WORDS 3456
#define XB_SPIN_CAP (1u << 18)

__device__ __forceinline__ unsigned xb_ld(unsigned* p)              { return __hip_atomic_load(p, __ATOMIC_RELAXED, __HIP_MEMORY_SCOPE_AGENT); }
__device__ __forceinline__ unsigned xb_add(unsigned* p, unsigned v) { return __hip_atomic_fetch_add(p, v, __ATOMIC_RELAXED, __HIP_MEMORY_SCOPE_AGENT); }
__device__ __forceinline__ unsigned xb_xcc_id() { return (unsigned)__builtin_amdgcn_s_getreg((3 << 11) | 20) & 0xFu; }
#define XB_SPIN(cond, bar) do { unsigned _sp = 0; while (cond) { __builtin_amdgcn_s_sleep(1); \
    if ((++_sp & 255u) == 0u) { if (xb_ld(&(bar)[XB_TMO])) break; if (_sp > XB_SPIN_CAP) { atomicAdd(&(bar)[XB_TMO], 1u); break; } } } } while (0)

struct XcdBarrier {
    unsigned* bar; unsigned x;
    volatile LAS unsigned* st;
};

__device__ __forceinline__ XcdBarrier xcd_barrier_post(unsigned* bar, volatile LAS unsigned* st) {
    XcdBarrier b; b.bar = bar; b.x = xb_xcc_id(); b.st = st;
    if (threadIdx.x == 0) (void)xb_add(&bar[XB_XCNT(b.x)], 1u);
    return b;
}
__device__ __forceinline__ void xcd_barrier_complete(unsigned* bar, unsigned x, unsigned& nloc, unsigned& nx) {
    const unsigned G = gridDim.x * gridDim.y * gridDim.z;
    unsigned sum, cnt, mine, sp = 0u;
    for (;;) {
        sum = 0u; cnt = 0u; mine = 0u;
#pragma unroll
        for (unsigned j = 0; j < 16; ++j) { const unsigned c = xb_ld(&bar[XB_XCNT(j)]); sum += c; cnt += (c > 0u) ? 1u : 0u; mine = (j == x) ? c : mine; }
        if (sum == G) break;
        __builtin_amdgcn_s_sleep(1);
        if ((++sp & 255u) == 0u) { if (xb_ld(&bar[XB_TMO])) break; if (sp > XB_SPIN_CAP) { atomicAdd(&bar[XB_TMO], 1u); break; } }
    }
    nloc = mine > 0u ? mine : 1u; nx = cnt > 0u ? cnt : 1u;
}

__device__ __forceinline__ void xcd_barrier(const XcdBarrier& b) {
    asm volatile("s_waitcnt vmcnt(0)" ::: "memory");
    __syncthreads();
    if (threadIdx.x == 0) {
        unsigned* bar = b.bar;
        __builtin_amdgcn_s_waitcnt(0);
        unsigned nloc = b.st[0], nx = b.st[1];
        if (nloc == 0u) { xcd_barrier_complete(bar, b.x, nloc, nx); b.st[0] = nloc; b.st[1] = nx; }
        const unsigned old = xb_add(&bar[XB_XSUB(b.x)], 1u);
        const unsigned gen = old / nloc;
        if (old + 1u == (gen + 1u) * nloc) {
            __builtin_amdgcn_fence(__ATOMIC_RELEASE, "agent");
            asm volatile("s_waitcnt vmcnt(0)" ::: "memory");
            const unsigned og = xb_add(&bar[XB_TOP], 1u);
            const unsigned tg = og / nx;
            if (og + 1u == (tg + 1u) * nx) xb_add(&bar[XB_TOPGEN], 1u);
            else XB_SPIN(xb_ld(&bar[XB_TOPGEN]) == tg, bar);
            __builtin_amdgcn_fence(__ATOMIC_ACQUIRE, "agent");
            xb_add(&bar[XB_XGEN(b.x)], 1u);
            asm volatile("s_waitcnt vmcnt(0)" ::: "memory");
        } else {
            XB_SPIN(xb_ld(&bar[XB_XGEN(b.x)]) == gen, bar);
            __builtin_amdgcn_fence(__ATOMIC_ACQUIRE, "agent");
            asm volatile("s_waitcnt vmcnt(0)" ::: "memory");
        }
    }
    __syncthreads();
}


__device__ __forceinline__ void p6_norm_ab(const Args& a, LAS unsigned char* lds) {
    const int tid = threadIdx.x, lane = tid & 63, wave = tid >> 6;
    const int gw = blockIdx.x * NW + wave, NGW = gridDim.x * NW;
    unsigned char* ws = a.ws;
    LAS float* Wl = (LAS float*)lds;
    { const float* wc = (const float*)a.in[12];
      for (int i = tid; i < 16 * 1024; i += NTHR) { const int k = i >> 4, c = i & 15; Wl[c * 1024 + k] = wc[(size_t)k * 4112 + 4096 + c]; } }
    __syncthreads();
    const float* X = (const float*)a.in[0]; const bf16* DL = (const bf16*)(ws + RGN(1)); float* H1 = a.out; const float* g = (const float*)a.in[11]; bf16* XN = (bf16*)(ws + RGN(0));
    float* Gb = (float*)(ws + O_G); float* Bb = (float*)(ws + O_BETA);
    const float* alog = (const float*)a.in[14]; const float* dtb = (const float*)a.in[15];
    f32x4 gv[4];
#pragma unroll
    for (int j = 0; j < 4; ++j) gv[j] = *(const f32x4*)(g + 4 * lane + 256 * j);
    f32x4 nv[4]; v2u nd[4];
    { const int m0 = gw < T_ ? gw : 0; const f32x4* xr = (const f32x4*)(X + (size_t)m0 * D_) + lane; const v2u* dr = (const v2u*)(DL + (size_t)m0 * D_) + lane;
#pragma unroll
      for (int j = 0; j < 4; ++j) { nv[j] = __builtin_nontemporal_load(xr + 64 * j); nd[j] = __builtin_nontemporal_load(dr + 64 * j); } }
    for (int m = gw; m < T_; m += NGW) {
        f32x4 v[4]; float s = 0.f;
        { const int mn = (m + NGW < T_) ? m + NGW : m; const f32x4* xn = (const f32x4*)(X + (size_t)mn * D_) + lane; const v2u* dn = (const v2u*)(DL + (size_t)mn * D_) + lane;
#pragma unroll
          for (int j = 0; j < 4; ++j) { v[j].x = nv[j].x + bflo(nd[j].x); v[j].y = nv[j].y + bfhi(nd[j].x); v[j].z = nv[j].z + bflo(nd[j].y); v[j].w = nv[j].w + bfhi(nd[j].y); nv[j] = __builtin_nontemporal_load(xn + 64 * j); nd[j] = __builtin_nontemporal_load(dn + 64 * j); } }
        { f32x4* hw = (f32x4*)(H1 + (size_t)m * D_) + lane;
#pragma unroll
          for (int j = 0; j < 4; ++j) __builtin_nontemporal_store(v[j], hw + 64 * j); }
#pragma unroll
        for (int j = 0; j < 4; ++j) s += (v[j].x * v[j].x + v[j].y * v[j].y) + (v[j].z * v[j].z + v[j].w * v[j].w);
        const float rs = rsqrtf(wave_sum(s) * (1.f / D_) + EPS);
        v2u* o8 = (v2u*)(XN + (size_t)m * D_) + lane;
#pragma unroll
        for (int j = 0; j < 4; ++j) { v[j] = v[j] * rs * gv[j]; v2u o; o.x = pk2(v[j].x, v[j].y); o.y = pk2(v[j].z, v[j].w); o8[64 * j] = o; }
        asm volatile("" ::: "memory");
        float acc[16];
#pragma unroll
        for (int c = 0; c < 16; ++c) { float s2 = 0.f;
#pragma unroll
            for (int j = 0; j < 4; ++j) { const f32x4 w = *(const LAS f32x4*)(Wl + c * 1024 + 256 * j + 4 * lane); s2 += (v[j].x * w.x + v[j].y * w.y) + (v[j].z * w.z + v[j].w * w.w); }
            acc[c] = s2; }
        float r8[8], r4[4], r2[2], mine;
        { const bool hi = lane & 32;
#pragma unroll
          for (int c = 0; c < 8; ++c) { const float snd = hi ? acc[c] : acc[8 + c]; const float kp = hi ? acc[8 + c] : acc[c]; r8[c] = kp + __shfl_xor(snd, 32); } }
        { const bool hi = lane & 16;
#pragma unroll
          for (int c = 0; c < 4; ++c) { const float snd = hi ? r8[c] : r8[4 + c]; const float kp = hi ? r8[4 + c] : r8[c]; r4[c] = kp + __shfl_xor(snd, 16); } }
        { const bool hi = lane & 8;
#pragma unroll
          for (int c = 0; c < 2; ++c) { const float snd = hi ? r4[c] : r4[2 + c]; const float kp = hi ? r4[2 + c] : r4[c]; r2[c] = kp + __shfl_xor(snd, 8); } }
        { const bool hi = lane & 4; const float snd = hi ? r2[0] : r2[1]; const float kp = hi ? r2[1] : r2[0]; mine = kp + __shfl_xor(snd, 4); }
        mine += __shfl_xor(mine, 2); mine += __shfl_xor(mine, 1);
        const int colc = lane >> 2;
        if ((lane & 3) == 0) {
            if (colc < 8) { const float xx = mine + dtb[colc]; const float sp = fmaxf(xx, 0.f) + __logf(1.f + __expf(-fabsf(xx))); Gb[(size_t)m * 8 + colc] = -__expf(alog[colc]) * sp; }
            else { Bb[(size_t)m * 8 + colc - 8] = __builtin_amdgcn_rcpf(1.f + __expf(-mine)); } }
    }
}

__device__ __forceinline__ void p8a_conv(const Args& a) {
    const int tid = threadIdx.x, lane = tid & 63, wave = tid >> 6;
    const int gw = blockIdx.x * NW + wave, NGW = gridDim.x * NW;
    unsigned char* ws = a.ws; const float* cw = (const float*)a.in[13];
    for (int it = gw; it < 2048 * 6; it += NGW) {
        const int grp = it / 6, sub = it % 6, which = sub >> 1, half = sub & 1;
        const int col = half * 512 + 8 * lane, ch = which * 1024 + col;
        const bf16* src = (const bf16*)(ws + RGN(1 + which)); bf16* dst = (bf16*)(ws + (which == 0 ? RGN(5) : which == 1 ? RGN(6) : RGN(0)));
        const int t0 = grp * 16, ts0 = t0 & (S_ - 1);
        float w[4][8];
#pragma unroll
        for (int j = 0; j < 4; ++j) { const f32x4 w0 = *(const f32x4*)(cw + (size_t)j * 3072 + ch), w1 = *(const f32x4*)(cw + (size_t)j * 3072 + ch + 4);
            w[j][0] = w0.x; w[j][1] = w0.y; w[j][2] = w0.z; w[j][3] = w0.w; w[j][4] = w1.x; w[j][5] = w1.y; w[j][6] = w1.z; w[j][7] = w1.w; }
        v4u xr[19];
#pragma unroll
        for (int i = 0; i < 19; ++i) { const v4u z4 = {0u, 0u, 0u, 0u}; const bool ok = (i >= 3 || ts0 > 0); const int ti = ok ? t0 - 3 + i : t0;
            const v4u ld = __builtin_nontemporal_load((const v4u*)(src + (size_t)ti * 1024 + col)); xr[i] = ok ? ld : z4; }
#pragma unroll
        for (int o = 0; o < 16; ++o) {
            float y[8];
#pragma unroll
            for (int e = 0; e < 8; ++e) y[e] = 0.f;
#pragma unroll
            for (int j = 0; j < 4; ++j) { const v4u v = xr[o + j];
                y[0] += w[j][0] * bflo(v.x); y[1] += w[j][1] * bfhi(v.x); y[2] += w[j][2] * bflo(v.y); y[3] += w[j][3] * bfhi(v.y);
                y[4] += w[j][4] * bflo(v.z); y[5] += w[j][5] * bfhi(v.z); y[6] += w[j][6] * bflo(v.w); y[7] += w[j][7] * bfhi(v.w); }
            float ss = 0.f;
#pragma unroll
            for (int e = 0; e < 8; ++e) { y[e] = silu(y[e]); ss += y[e] * y[e]; }
            float sc = 1.f;
            if (which < 2) { ss = row16_sum(ss);
                sc = rsqrtf(ss + EPS); if (which == 0) sc *= 0.08838834764831845f; }
            v4u ov; ov.x = pk2(y[0] * sc, y[1] * sc); ov.y = pk2(y[2] * sc, y[3] * sc); ov.z = pk2(y[4] * sc, y[5] * sc); ov.w = pk2(y[6] * sc, y[7] * sc);
            *(v4u*)(dst + (size_t)(t0 + o) * 1024 + col) = ov;
        }
    }
}

constexpr int TS = 272, TILE = 17408, L_SET = 2 * TILE, L_M = 2 * L_SET, L_GC = L_M + 4 * TILE;
#define MFMA16(A, B, C) __builtin_amdgcn_mfma_f32_16x16x32_bf16(A, B, C, 0, 0, 0)
__device__ __forceinline__ void p8b_chunk(const Args& a, LAS unsigned char* lds) {
    const int tid0 = threadIdx.x;
    unsigned char* ws = a.ws;
    bf16* QN = (bf16*)(ws + RGN(5)); bf16* KN = (bf16*)(ws + RGN(6)); const bf16* VN = (const bf16*)(ws + RGN(0));
    bf16* KDT = (bf16*)(ws + RGN(1)); bf16* ATT = (bf16*)(ws + RGN(2)); bf16* UT = (bf16*)(ws + RGN(3));
    bf16* QOUT = a.dry ? KDT : QN; bf16* WOUT = a.dry ? UT : KN;
    const float* Gb = (const float*)(ws + O_G); const float* Bb = (const float*)(ws + O_BETA); float* GL = (float*)(ws + O_GL);
    for (int base = blockIdx.x * 4; base < 4096; base += gridDim.x * 4) {
        int tid = tid0; asm volatile("" : "+v"(tid));
        const int lane = tid & 63, wave = __builtin_amdgcn_readfirstlane(tid >> 6), c = lane & 15, g = lane >> 4;
        const int bh = base >> 7, b = bh >> 3, h = bh & 7;
        const size_t tokb = (size_t)b * S_ + (size_t)(base & 127) * 64;
        const int r0 = tid >> 4, ch = tid & 15;
        if (wave < 4) { LAS float* gcs = (LAS float*)(lds + L_GC + wave * 1024); const size_t t0 = tokb + wave * 64;
            float gv = Gb[(t0 + lane) * 8 + h];
#pragma unroll
            for (int o = 1; o < 64; o <<= 1) { const float t = __shfl_up(gv, o); if (lane >= o) gv += t; }
            const float g63 = __shfl(gv, 63);
            gcs[lane] = gv; gcs[64 + lane] = __expf(gv); gcs[128 + lane] = Bb[(t0 + lane) * 8 + h]; gcs[192 + lane] = __expf(g63 - gv);
            if (lane == 63) GL[base + wave] = __expf(gv); }
        v4u pa0, pa1, pb0, pb1;
        { const size_t go = (tokb + r0) * 1024 + h * 128 + ch * 8;
          pa0 = __builtin_nontemporal_load((const v4u*)(QN + go)); pa1 = __builtin_nontemporal_load((const v4u*)(QN + go + 32 * 1024)); pb0 = *(const v4u*)(KN + go); pb1 = *(const v4u*)(KN + go + 32 * 1024);
          *(LAS v4u*)(lds + r0 * TS + ch * 16) = pa0; *(LAS v4u*)(lds + (r0 + 32) * TS + ch * 16) = pa1;
          *(LAS v4u*)(lds + TILE + r0 * TS + ch * 16) = pb0; *(LAS v4u*)(lds + TILE + (r0 + 32) * TS + ch * 16) = pb1; }
        __syncthreads();
#pragma unroll 1
        for (int bc = 0; bc < 4; ++bc) {
            const int cidx = base + bc;
            if (bc < 3) { const size_t go = (tokb + (bc + 1) * 64 + r0) * 1024 + h * 128 + ch * 8;
                pa0 = __builtin_nontemporal_load((const v4u*)(QN + go)); pa1 = __builtin_nontemporal_load((const v4u*)(QN + go + 32 * 1024)); pb0 = *(const v4u*)(KN + go); pb1 = *(const v4u*)(KN + go + 32 * 1024); }
            const int sQ = (bc & 1) * L_SET, sK = sQ + TILE;
            LAS float* gcs = (LAS float*)(lds + L_GC + bc * 1024); LAS float* Ml = (LAS float*)(lds + L_M + bc * TILE);
#pragma unroll 1
            for (int rr = 0; rr < 4; ++rr) {
                const int tsk = wave + 8 * rr, isM = tsk >> 4, tt = tsk & 15, ib = tt >> 2, jb = tt & 3;
                const int i = 16 * ib + c, j0 = 16 * jb + 4 * g;
                const int aoff = ((ib * 2 + (jb >> 1)) * 64 + (2 * (jb & 1) + (g >> 1)) * 16 + c) * 8 + ((4 * g) & 7);
                if (jb <= ib) {
                    f32x4 acc = {0.f, 0.f, 0.f, 0.f};
                    const int xs = isM ? sK : sQ;
#pragma unroll
                    for (int ks = 0; ks < 4; ++ks) {
                        const bf16x8 A = *(const LAS bf16x8*)(lds + sK + (16 * jb + c) * TS + (32 * ks + 8 * g) * 2);
                        const bf16x8 B = *(const LAS bf16x8*)(lds + xs + (16 * ib + c) * TS + (32 * ks + 8 * g) * 2);
                        acc = MFMA16(A, B, acc); }
                    const float gi = gcs[i]; float e[4];
#pragma unroll
                    for (int ii = 0; ii < 4; ++ii) e[ii] = __expf(gi - gcs[j0 + ii]);
                    if (isM) { const float bi = gcs[128 + i]; f32x4 m;
                        m.x = (i > j0 + 0) ? bi * acc[0] * e[0] : 0.f; m.y = (i > j0 + 1) ? bi * acc[1] * e[1] : 0.f; m.z = (i > j0 + 2) ? bi * acc[2] * e[2] : 0.f; m.w = (i > j0 + 3) ? bi * acc[3] * e[3] : 0.f;
                        *(LAS f32x4*)(Ml + i * 68 + j0) = m;
                    } else { const float a0 = (i >= j0 + 0) ? acc[0] * e[0] : 0.f, a1 = (i >= j0 + 1) ? acc[1] * e[1] : 0.f, a2 = (i >= j0 + 2) ? acc[2] * e[2] : 0.f, a3 = (i >= j0 + 3) ? acc[3] * e[3] : 0.f;
                        v2u o; o.x = pk2(a0, a1); o.y = pk2(a2, a3); *(v2u*)(ATT + (size_t)cidx * 4096 + aoff) = o; }
                } else if (!isM) { const v2u o = {0u, 0u}; *(v2u*)(ATT + (size_t)cidx * 4096 + aoff) = o; }
                else { const f32x4 z = {0.f, 0.f, 0.f, 0.f}; *(LAS f32x4*)(Ml + i * 68 + j0) = z; }
            }
            for (int i2 = tid; i2 < 1024; i2 += NTHR) { const int row = i2 >> 4, cc = i2 & 15; const v4u v = *(const LAS v4u*)(lds + sQ + row * TS + cc * 16); const float e = gcs[64 + row]; v4u o;
                o.x = pk2(bflo(v.x) * e, bfhi(v.x) * e); o.y = pk2(bflo(v.y) * e, bfhi(v.y) * e); o.z = pk2(bflo(v.z) * e, bfhi(v.z) * e); o.w = pk2(bflo(v.w) * e, bfhi(v.w) * e);
                const int R = 4 * ((row >> 4) * 4 + (cc >> 2)) + (cc & 3), C = (row & 15) * 8;
                *(v4u*)(QOUT + (tokb + bc * 64 + R) * 1024 + h * 128 + C) = o; }
            if (bc < 3) { const int sn = ((bc + 1) & 1) * L_SET;
                *(LAS v4u*)(lds + sn + r0 * TS + ch * 16) = pa0; *(LAS v4u*)(lds + sn + (r0 + 32) * TS + ch * 16) = pa1;
                *(LAS v4u*)(lds + sn + TILE + r0 * TS + ch * 16) = pb0; *(LAS v4u*)(lds + sn + TILE + (r0 + 32) * TS + ch * 16) = pb1; }
            __syncthreads();
        }
        { const size_t go = (tokb + r0) * 1024 + h * 128 + ch * 8;
          pa0 = __builtin_nontemporal_load((const v4u*)(KN + go)); pa1 = __builtin_nontemporal_load((const v4u*)(KN + go + 32 * 1024)); pb0 = __builtin_nontemporal_load((const v4u*)(VN + go)); pb1 = __builtin_nontemporal_load((const v4u*)(VN + go + 32 * 1024));
          *(LAS v4u*)(lds + r0 * TS + ch * 16) = pa0; *(LAS v4u*)(lds + (r0 + 32) * TS + ch * 16) = pa1;
          *(LAS v4u*)(lds + TILE + r0 * TS + ch * 16) = pb0; *(LAS v4u*)(lds + TILE + (r0 + 32) * TS + ch * 16) = pb1; }
        if (wave < 4) {
            LAS float* Ml = (LAS float*)(lds + L_M + wave * TILE);
            float Tc[64];
            f32x4 mrow[16], mnxt[16];
#pragma unroll
            for (int i = 0; i < 64; ++i) {
#pragma unroll
                for (int j4 = 0; j4 < (i + 4) / 4 && i + 1 < 64; ++j4) mnxt[j4] = *(const LAS f32x4*)(Ml + (i + 1) * 68 + 4 * j4);
                f32x4 acc = {0.f, 0.f, 0.f, 0.f};
#pragma unroll
                for (int j4 = 0; j4 < (i + 3) / 4; ++j4) {
                    const f32x4 m = mrow[j4];
                    if (4 * j4 + 0 < i) acc.x += m.x * Tc[4 * j4 + 0];
                    if (4 * j4 + 1 < i) acc.y += m.y * Tc[4 * j4 + 1];
                    if (4 * j4 + 2 < i) acc.z += m.z * Tc[4 * j4 + 2];
                    if (4 * j4 + 3 < i) acc.w += m.w * Tc[4 * j4 + 3];
                }
                int l2 = lane; asm volatile("" : "+v"(l2));
                Tc[i] = ((l2 == i) ? 1.f : 0.f) - ((acc.x + acc.y) + (acc.z + acc.w));
#pragma unroll
                for (int j4 = 0; j4 < 16; ++j4) mrow[j4] = mnxt[j4];
            }
            asm volatile("" ::: "memory");
#pragma unroll
            for (int i = 0; i < 64; ++i) Ml[i * 68 + lane] = Tc[i];
        }
        __syncthreads();
#pragma unroll 1
        for (int bc = 0; bc < 4; ++bc) {
            const int cidx = base + bc; const size_t tok0 = tokb + bc * 64;
            if (bc < 3) { const size_t go = (tokb + (bc + 1) * 64 + r0) * 1024 + h * 128 + ch * 8;
                pa0 = __builtin_nontemporal_load((const v4u*)(KN + go)); pa1 = __builtin_nontemporal_load((const v4u*)(KN + go + 32 * 1024)); pb0 = __builtin_nontemporal_load((const v4u*)(VN + go)); pb1 = __builtin_nontemporal_load((const v4u*)(VN + go + 32 * 1024)); }
            const int sK = (bc & 1) * L_SET, sV = sK + TILE;
            LAS float* gcs = (LAS float*)(lds + L_GC + bc * 1024); LAS float* Tl = (LAS float*)(lds + L_M + bc * TILE);
            { const int db = wave, q = (lane & 15) >> 2, p = lane & 3;
              bf16x8 Kt[2], Vt[2];
#pragma unroll
              for (int ks = 0; ks < 2; ++ks) { const int off = (32 * ks + 8 * g + q) * TS + (16 * db + 4 * p) * 2;
                  Kt[ks] = cat8(vtr(lds + sK + off), vtr(lds + sK + off + 4 * TS));
                  Vt[ks] = cat8(vtr(lds + sV + off), vtr(lds + sV + off + 4 * TS)); }
#pragma unroll
              for (int ks = 0; ks < 2; ++ks) { const int jb0 = 32 * ks + 8 * g; const v4u kk = __builtin_bit_cast(v4u, Kt[ks]);
                  const f32x4 d0 = *(const LAS f32x4*)(gcs + 192 + jb0), d1 = *(const LAS f32x4*)(gcs + 192 + jb0 + 4); v4u o;
                  o.x = pk2(bflo(kk.x) * d0.x, bfhi(kk.x) * d0.y); o.y = pk2(bflo(kk.y) * d0.z, bfhi(kk.y) * d0.w); o.z = pk2(bflo(kk.z) * d1.x, bfhi(kk.z) * d1.y); o.w = pk2(bflo(kk.w) * d1.z, bfhi(kk.w) * d1.w);
                  *(v4u*)(KDT + (size_t)cidx * 8192 + ((db * 2 + ks) * 64 + lane) * 8) = o; }
              f32x4 su[2][2], sw[2][2];
#pragma unroll
              for (int ks = 0; ks < 2; ++ks)
#pragma unroll
                  for (int hf = 0; hf < 2; ++hf) { su[ks][hf] = *(const LAS f32x4*)(gcs + 128 + 32 * ks + 8 * g + 4 * hf); sw[ks][hf] = su[ks][hf] * *(const LAS f32x4*)(gcs + 64 + 32 * ks + 8 * g + 4 * hf); }
#pragma unroll
              for (int ib = 0; ib < 4; ++ib) {
                  f32x4 aw = {0.f, 0.f, 0.f, 0.f}, au = {0.f, 0.f, 0.f, 0.f};
#pragma unroll
                  for (int ks = 0; ks < 2; ++ks) {
                      const f32x4 t0 = *(const LAS f32x4*)(Tl + (16 * ib + c) * 68 + 32 * ks + 8 * g), t1 = *(const LAS f32x4*)(Tl + (16 * ib + c) * 68 + 32 * ks + 8 * g + 4);
                      const f32x4 w0 = t0 * sw[ks][0], w1 = t1 * sw[ks][1], u0 = t0 * su[ks][0], u1 = t1 * su[ks][1];
                      const bf16x8 Bw = pack8(w0.x, w0.y, w0.z, w0.w, w1.x, w1.y, w1.z, w1.w);
                      const bf16x8 Au = pack8(u0.x, u0.y, u0.z, u0.w, u1.x, u1.y, u1.z, u1.w);
                      aw = MFMA16(Kt[ks], Bw, aw); au = MFMA16(Au, Vt[ks], au); }
                  { v2u o; o.x = pk2(aw[0], aw[1]); o.y = pk2(aw[2], aw[3]); const int R = 4 * (ib * 4 + (db >> 1)) + ((2 * db + (g >> 1)) & 3), C = c * 8 + ((4 * g) & 7);
                    *(v2u*)(WOUT + (tok0 + R) * 1024 + h * 128 + C) = o; }
                  { v2u o; o.x = pk2(au[0], au[1]); o.y = pk2(au[2], au[3]); *(v2u*)(UT + (size_t)cidx * 8192 + ((db * 4 + ib) * 64 + lane) * 4) = o; }
              }
            }
            if (bc < 3) { const int sn = ((bc + 1) & 1) * L_SET;
                *(LAS v4u*)(lds + sn + r0 * TS + ch * 16) = pa0; *(LAS v4u*)(lds + sn + (r0 + 32) * TS + ch * 16) = pa1;
                *(LAS v4u*)(lds + sn + TILE + r0 * TS + ch * 16) = pb0; *(LAS v4u*)(lds + sn + TILE + (r0 + 32) * TS + ch * 16) = pb1; }
            __syncthreads();
        }
    }
}

__device__ __forceinline__ void p9_scan(const Args& a, LAS unsigned char* lds) {
    const int tid = threadIdx.x, lane = tid & 63, wave = __builtin_amdgcn_readfirstlane(tid >> 6), c = lane & 15, g = lane >> 4;
    unsigned char* ws = a.ws;
    const bf16* QD = (const bf16*)(ws + RGN(5)); const bf16* W = (const bf16*)(ws + RGN(6)); const bf16* KDT = (const bf16*)(ws + RGN(1));
    const bf16* ATT = (const bf16*)(ws + RGN(2)); const bf16* UT = (const bf16*)(ws + RGN(3)); bf16* O = (bf16*)(ws + RGN(0)); const float* GL = (const float*)(ws + O_GL);
    const bool first = wave < 4; const int wq = wave & 3;
    constexpr int L_ST = 0, L_VT = 4352;
    for (int it = blockIdx.x; it < 256; it += gridDim.x) {
        const int xcd = it & 7, jj = it >> 3, bh = xcd * 4 + (jj >> 3), slice = jj & 7, b = bh >> 3, h = bh & 7;
        __syncthreads();
        for (int i = tid; i < 4352 / 4; i += NTHR) ((LAS unsigned*)(lds + L_ST))[i] = 0u;
        if (tid < 128) ((LAS float*)(lds + 8192))[tid] = GL[bh * 128 + tid];
        __syncthreads();
        f32x4 Sacc = {0.f, 0.f, 0.f, 0.f};
        const bf16* Ap = (first ? W : QD) + ((size_t)b * S_ + 16 * wq + g) * 1024 + h * 128 + c * 8;
        const bf16* Up = UT + (size_t)(bh * 128) * 8192 + ((slice * 4 + wq) * 64 + lane) * 4;
        const bf16* Xp = ATT + (size_t)(bh * 128) * 4096 + ((wq * 2) * 64 + lane) * 8;
        const size_t ustep = first ? 8192 : 0, xstep = first ? 0 : 4096;
        const bf16* Kp = KDT + (size_t)(bh * 128) * 8192 + ((wave * 2) * 64 + lane) * 8;
        const bool dummy_st = first;
        bf16* Op = dummy_st ? (bf16*)(ws + RGN(2) + 32 * MiB) + (size_t)(blockIdx.x * 8 + wave) * 4096 + lane : O + ((size_t)b * S_ + 16 * wq + 4 * g) * 1024 + h * 128 + slice * 16 + c;
        const size_t ostep = dummy_st ? 0 : 65536;
        const int vtoff = first ? L_VT + c * 144 + (16 * wq + 4 * g) * 2 : L_VT + 2304 + lane * 8;
        bf16x8 Af[4][4], Xf[4][2], Kd[4][2]; v2u uu[4]; float gl[4];
#define SCAN_LOAD(slot, nn) do { \
            _Pragma("unroll") for (int ks = 0; ks < 4; ++ks) Af[slot][ks] = *(const bf16x8*)(Ap + (size_t)(nn) * 65536 + 4096 * ks); \
            _Pragma("unroll") for (int ks = 0; ks < 2; ++ks) Kd[slot][ks] = *(const bf16x8*)(Kp + (size_t)(nn) * 8192 + 512 * ks); \
            uu[slot] = *(const v2u*)(Up + (size_t)(nn) * ustep); Xf[slot][0] = *(const bf16x8*)(Xp + (size_t)(nn) * xstep); Xf[slot][1] = *(const bf16x8*)(Xp + (size_t)(nn) * xstep + 512); \
            gl[slot] = ((const LAS float*)(lds + 8192))[nn]; } while (0)
#pragma unroll
        for (int s4 = 0; s4 < 4; ++s4) { SCAN_LOAD(s4, s4); __builtin_amdgcn_sched_barrier(0); }
#pragma unroll 1
        for (int n0 = 0; n0 < 128; n0 += 4) {
#pragma unroll
            for (int s4 = 0; s4 < 4; ++s4) {
                const int n = n0 + s4;
                f32x4 acc = {0.f, 0.f, 0.f, 0.f}, acc2 = {0.f, 0.f, 0.f, 0.f};
                { const bf16x8 S0 = *(const LAS bf16x8*)(lds + L_ST + c * 272 + (8 * g) * 2), S1 = *(const LAS bf16x8*)(lds + L_ST + c * 272 + (32 + 8 * g) * 2);
                  const bf16x8 S2 = *(const LAS bf16x8*)(lds + L_ST + c * 272 + (64 + 8 * g) * 2), S3 = *(const LAS bf16x8*)(lds + L_ST + c * 272 + (96 + 8 * g) * 2);
                  acc = MFMA16(Af[s4][0], S0, acc); acc2 = MFMA16(Af[s4][1], S1, acc2); acc = MFMA16(Af[s4][2], S2, acc); acc2 = MFMA16(Af[s4][3], S3, acc2); acc = acc + acc2; }
                { v2u o; o.x = pk2(bflo(uu[s4].x) - acc[0], bfhi(uu[s4].x) - acc[1]); o.y = pk2(bflo(uu[s4].y) - acc[2], bfhi(uu[s4].y) - acc[3]);
                    *(LAS v2u*)(lds + vtoff) = o; }
                __syncthreads();
                bf16x8 Vb[2];
#pragma unroll
                for (int ks = 0; ks < 2; ++ks) Vb[ks] = *(const LAS bf16x8*)(lds + L_VT + c * 144 + (32 * ks + 8 * g) * 2);
                { acc = MFMA16(Xf[s4][0], Vb[0], acc); acc = MFMA16(Xf[s4][1], Vb[1], acc);
                    bf16* op = Op + (size_t)n * ostep; const unsigned p01 = pk2(acc[0], acc[1]), p23 = pk2(acc[2], acc[3]);
                    op[0] = (bf16)(p01 & 0xffffu); op[1024] = (bf16)(p01 >> 16); op[2048] = (bf16)(p23 & 0xffffu); op[3072] = (bf16)(p23 >> 16); }
                Sacc = Sacc * gl[s4];
                Sacc = MFMA16(Kd[s4][0], Vb[0], Sacc); Sacc = MFMA16(Kd[s4][1], Vb[1], Sacc);
                { v2u o; o.x = pk2(Sacc[0], Sacc[1]); o.y = pk2(Sacc[2], Sacc[3]); *(LAS v2u*)(lds + L_ST + c * 272 + (16 * wave + 4 * g) * 2) = o; }
                const int nl = (n + 4 < 128) ? n + 4 : n;
                SCAN_LOAD(s4, nl);
                __syncthreads();
            }
        }
#undef SCAN_LOAD
    }
}

__device__ __forceinline__ void p10_gate(const Args& a) {
    const int tid = threadIdx.x, lane = tid & 63, wave = tid >> 6;
    const int gw = blockIdx.x * NW + wave, NGW = gridDim.x * NW;
    unsigned char* ws = a.ws;
    const bf16* O = (const bf16*)(ws + RGN(0)); const bf16* Z = (const bf16*)(ws + RGN(4)); bf16* Y1 = (bf16*)(ws + RGN(1));
    const float* on = (const float*)a.in[16];
    float gn[16];
#pragma unroll
    for (int e = 0; e < 16; ++e) gn[e] = on[(16 * lane + e) & 127];
    for (int m = gw; m < T_; m += NGW) {
        const size_t off = (size_t)m * 1024 + 16 * lane;
        const v4u o0 = __builtin_nontemporal_load((const v4u*)(O + off)), o1 = __builtin_nontemporal_load((const v4u*)(O + off + 8)), z0 = __builtin_nontemporal_load((const v4u*)(Z + off)), z1 = __builtin_nontemporal_load((const v4u*)(Z + off + 8));
        float ov[16] = {bflo(o0.x), bfhi(o0.x), bflo(o0.y), bfhi(o0.y), bflo(o0.z), bfhi(o0.z), bflo(o0.w), bfhi(o0.w), bflo(o1.x), bfhi(o1.x), bflo(o1.y), bfhi(o1.y), bflo(o1.z), bfhi(o1.z), bflo(o1.w), bfhi(o1.w)};
        const float zv[16] = {bflo(z0.x), bfhi(z0.x), bflo(z0.y), bfhi(z0.y), bflo(z0.z), bfhi(z0.z), bflo(z0.w), bfhi(z0.w), bflo(z1.x), bfhi(z1.x), bflo(z1.y), bfhi(z1.y), bflo(z1.z), bfhi(z1.z), bflo(z1.w), bfhi(z1.w)};
        float ss = 0.f;
#pragma unroll
        for (int e = 0; e < 16; ++e) ss += ov[e] * ov[e];
        ss += __shfl_xor(ss, 1); ss += __shfl_xor(ss, 2); ss += __shfl_xor(ss, 4);
        const float rs = rsqrtf(ss * (1.f / 128.f) + EPS);
#pragma unroll
        for (int e = 0; e < 16; ++e) ov[e] = ov[e] * rs * gn[e] * silu(zv[e]);
        v4u r0, r1; r0.x = pk2(ov[0], ov[1]); r0.y = pk2(ov[2], ov[3]); r0.z = pk2(ov[4], ov[5]); r0.w = pk2(ov[6], ov[7]);
        r1.x = pk2(ov[8], ov[9]); r1.y = pk2(ov[10], ov[11]); r1.z = pk2(ov[12], ov[13]); r1.w = pk2(ov[14], ov[15]);
        *(v4u*)(Y1 + off) = r0; *(v4u*)(Y1 + off + 8) = r1;
    }
}

__device__ __forceinline__ void p12_final(const Args& a) {
    const int tid = threadIdx.x, lane = tid & 63, wave = tid >> 6;
    const int gw = blockIdx.x * NW + wave, NGW = gridDim.x * NW;
    const float* g = (const float*)a.in[18];
    f32x4 gv[4];
#pragma unroll
    for (int j = 0; j < 4; ++j) gv[j] = *(const f32x4*)(g + 4 * lane + 256 * j);
    const bf16* DL = (const bf16*)(a.ws + RGN(2));
    f32x4 nv[4]; v2u nd[4];
    { const int m0 = gw < T_ ? gw : 0; const f32x4* xr0 = (const f32x4*)(a.out + (size_t)m0 * D_) + lane; const v2u* dr = (const v2u*)(DL + (size_t)m0 * D_) + lane;
#pragma unroll
      for (int j = 0; j < 4; ++j) { nv[j] = __builtin_nontemporal_load(xr0 + 64 * j); nd[j] = __builtin_nontemporal_load(dr + 64 * j); } }
    for (int m = gw; m < T_; m += NGW) {
        f32x4* xw = (f32x4*)(a.out + (size_t)m * D_) + lane; f32x4 v[4]; float s = 0.f;
        { const int mn = (m + NGW < T_) ? m + NGW : m; const f32x4* xn = (const f32x4*)(a.out + (size_t)mn * D_) + lane; const v2u* dn = (const v2u*)(DL + (size_t)mn * D_) + lane;
#pragma unroll
          for (int j = 0; j < 4; ++j) { v[j].x = nv[j].x + bflo(nd[j].x); v[j].y = nv[j].y + bfhi(nd[j].x); v[j].z = nv[j].z + bflo(nd[j].y); v[j].w = nv[j].w + bfhi(nd[j].y); nv[j] = __builtin_nontemporal_load(xn + 64 * j); nd[j] = __builtin_nontemporal_load(dn + 64 * j); } }
#pragma unroll
        for (int j = 0; j < 4; ++j) s += (v[j].x * v[j].x + v[j].y * v[j].y) + (v[j].z * v[j].z + v[j].w * v[j].w);
        const float rs = rsqrtf(wave_sum(s) * (1.f / D_) + EPS);
#pragma unroll
        for (int j = 0; j < 4; ++j) __builtin_nontemporal_store(v[j] * rs * gv[j], xw + 64 * j);
    }
}

constexpr int NPH = 13;
__global__ void __launch_bounds__(NTHR, 2) fwd(Args a) {
    extern __shared__ __attribute__((aligned(16))) unsigned char smem[];
    LAS unsigned char* lds = (LAS unsigned char*)smem;
    cg::grid_group grid = cg::this_grid();
    unsigned char* ws = a.ws;
    const int G = gridDim.x, bx = blockIdx.x;
#define IN(k) (a.ph_lo <= (k) && (k) < a.ph_hi)
    volatile LAS unsigned* xst = (volatile LAS unsigned*)(lds + LDS_BYTES - 16);
    if (threadIdx.x < 4) xst[threadIdx.x] = 0u;
    __syncthreads();
    XcdBarrier xbar; xbar.bar = (unsigned*)(ws + O_BAR); xbar.x = 0; xbar.st = xst;
#define SEAM(k) do { if (IN(k) && IN((k) + 1)) xcd_barrier(xbar); } while (0)
    if (IN(0) && IN(1)) { if (blockIdx.x == 0) for (int i = threadIdx.x; i < XCD_BAR_WORDS; i += NTHR) ((unsigned*)(ws + O_BAR))[i] = 0u;
                          grid.sync(); xbar = xcd_barrier_post((unsigned*)(ws + O_BAR), xst); }
    if (IN(0)) p0_prologue(a, lds);
    SEAM(0);
    if (IN(1)) { pg8::Gemm g{(const bf16*)(ws + RGN(0)), (const bf16*)(ws + O_WIN0), T_, 2048, 1024}; pg8::StaticOrder S; S.init(T_, 2048, G, bx);
        pg8::EpiB E{(bf16*)(ws + RGN(1)), P0LD, 0, 0}; pg8::gemm_phase<pg8::EpiB, pg8::StaticOrder, true, true>(lds, g, S, E); }
    SEAM(1);
    if (IN(2)) p2_prep(a);
    SEAM(2);
    if (IN(3)) {
        { pg8::Gemm g{(const bf16*)(ws + RGN(5)), (const bf16*)(ws + O_WQKV), T_, 1792, 384}; pg8::StaticOrder S; S.init(T_, 1792, G, bx);
          pg8::EpiB E{(bf16*)(ws + O_QKV), 1792, 0, 0}; pg8::gemm_phase<pg8::EpiB, pg8::StaticOrder, true, true>(lds, g, S, E); }
        { pg8::Gemm g{(const bf16*)(ws + RGN(5) + 26 * MiB), (const bf16*)(ws + O_WPOOL), T_, 512, 512}; pg8::StaticOrder S; S.init(T_, 512, G, bx);
          pg8::EpiGate E{(bf16*)(ws + RGN(0)) + 512, 1024, (const bf16*)(ws + RGN(1)) + 1440, P0LD, (const float*)a.in[9]};
          pg8::gemm_phase<pg8::EpiGate, pg8::StaticOrder, true, true>(lds, g, S, E); }
    }
    SEAM(3);
    if (IN(4)) p4_attn(a, lds);
    SEAM(4);
    if (IN(5)) { pg8::Gemm g{(const bf16*)(ws + RGN(0)), (const bf16*)(ws + O_WOUTAB), T_, 1024, 1024}; pg8::StaticOrder S; S.init(T_, 1024, G, bx);
        pg8::EpiB E{(bf16*)(ws + RGN(1)), 1024, 0, 0}; pg8::gemm_phase<pg8::EpiB, pg8::StaticOrder, true, true>(lds, g, S, E); }
    SEAM(5);
    if (IN(6)) p6_norm_ab(a, lds);
    SEAM(6);
    if (IN(7)) { pg8::Gemm g{(const bf16*)(ws + RGN(0)), (const bf16*)(ws + O_WINC), T_, 4096, 1024}; pg8::StaticOrder S; S.init(T_, 4096, G, bx);
        pg8::EpiB E{(bf16*)(ws + RGN(1)), 1024, 1024, REG / 2}; pg8::gemm_phase<pg8::EpiB, pg8::StaticOrder, true, true>(lds, g, S, E); }
    SEAM(7);
    if (IN(8)) p8a_conv(a);
    SEAM(8);
    if (IN(9)) p8b_chunk(a, lds);
    SEAM(9);
    if (IN(10)) p9_scan(a, lds);
    SEAM(10);
    if (IN(11)) p10_gate(a);
    SEAM(11);
    if (IN(12)) { pg8::Gemm g{(const bf16*)(ws + RGN(1)), (const bf16*)(ws + O_WOUTC), T_, 1024, 1024}; pg8::StaticOrder S; S.init(T_, 1024, G, bx);
        pg8::EpiB E{(bf16*)(ws + RGN(2)), 1024, 0, 0}; pg8::gemm_phase<pg8::EpiB, pg8::StaticOrder, true, true>(lds, g, S, E); }
    SEAM(12);
    if (IN(13)) p12_final(a);
}

#ifndef MK_MULTI
#define MK_MULTI 0
#endif
extern "C" void kernel_launch(void* const* d_in, const int* in_sizes, int n_in, void* d_out, int out_size, void* d_ws, size_t ws_size, hipStream_t stream) {
    static int grid = 0;
    if (grid == 0) {
        if (n_in != 19 || out_size != T_ * D_ || ws_size < WS_NEED) { fprintf(stderr, "kernel_launch: unexpected shapes (n_in %d out %d ws %zu need %zu)\n", n_in, out_size, ws_size, (size_t)WS_NEED); grid = -1; return; }
        int dev = 0, cus = 0, per_cu = 0;
        hipGetDevice(&dev); hipDeviceGetAttribute(&cus, hipDeviceAttributeMultiprocessorCount, dev);
        if (hipFuncSetAttribute((const void*)fwd, hipFuncAttributeMaxDynamicSharedMemorySize, LDS_BYTES) != hipSuccess) { fprintf(stderr, "kernel_launch: hipFuncSetAttribute failed\n"); grid = -1; return; }
        hipOccupancyMaxActiveBlocksPerMultiprocessor(&per_cu, (const void*)fwd, NTHR, LDS_BYTES);
        (void)hipGetLastError();
        if (per_cu < 1) per_cu = 1;
        grid = cus * 1;
        if (grid > 256) grid = 256;
    }
    if (grid < 0) return;
    Args a{};
    for (int i = 0; i < 19; ++i) a.in[i] = d_in[i];
    a.out = (float*)d_out; a.ws = (unsigned char*)d_ws;
    for (int i = 0; i < 16; ++i) a.inv_freq[i] = 1.0f / powf(10000.0f, (float)i / 16.0f);
#if MK_MULTI
#ifndef PROBE_PH
#define PROBE_PH -1
#endif
#ifndef PROBE_REPS
#define PROBE_REPS 0
#endif
    for (int p = 0; p <= NPH; ++p) { const int reps = 1 + (p == PROBE_PH ? PROBE_REPS : 0);
        for (int r = 0; r < reps; ++r) { a.ph_lo = p; a.ph_hi = p + 1; a.dry = (p == 9 && r + 1 < reps) ? 1 : 0;
#ifdef PROBE_DRYMODE
            if (p == 10 && r + 1 < reps) a.dry = PROBE_DRYMODE;
#endif
            hipLaunchKernelGGL(fwd, dim3(grid), dim3(NTHR), LDS_BYTES, stream, a); } }
#else
    a.ph_lo = 0; a.ph_hi = NPH + 1;
    void* args[] = {&a};
    hipError_t e = hipLaunchCooperativeKernel((const void*)fwd, dim3(grid), dim3(NTHR), args, LDS_BYTES, stream);
    if (e != hipSuccess) fprintf(stderr, "cooperative launch failed: %s (grid %d)\n", hipGetErrorString(e), grid);
#endif
}
```

```cpp
#include <hip/hip_runtime.h>
#include <hip/hip_cooperative_groups.h>
#include <cstdio>
#include <cstdint>
#include <cmath>
namespace cg = cooperative_groups;
namespace pg8 {
#define PG8_LAS __attribute__((address_space(3)))
typedef unsigned short bf16_t;
typedef short bf16x8 __attribute__((ext_vector_type(8)));
typedef float f32x4 __attribute__((ext_vector_type(4)));
typedef unsigned u32x4 __attribute__((ext_vector_type(4)));
constexpr int BM = 256, BK = 64, HALF = 128, HTB = HALF * BK * 2  , STAGE_BYTES = 8 * HTB, NXCD = 8, WGM = 8;

__host__ __device__ __forceinline__ int lds_byte(int r, int c) { const int st = (r >> 4) * 2 + (c >> 5), rr = r & 15, cc = c & 31, ob = rr * 64 + cc * 2; return st * 1024 + (ob ^ (((ob >> 9) & 1) << 5)); }
__host__ __device__ __forceinline__ void stage_rc(int b, int& R, int& C) { const int st = b / 1024, sb = b % 1024, swz = sb ^ (((sb >> 9) & 1) << 5); R = (st >> 1) * 16 + swz / 64; C = (st & 1) * 32 + (swz % 64) / 2; }
__host__ __device__ __forceinline__ int perm32(int rho) { const int n = rho >> 4, i = rho & 15; return 8 * (i >> 2) + 4 * n + (i & 3); }

struct Unit { int pm, pn; };
struct Gemm { const bf16_t* A; const bf16_t* Bt; int M, N, K; };

struct StaticOrder {
    int nM, nN, nwg, G, c;
    __host__ __device__ void init(int M, int N, int G_, int c_) { nM = M / BM; nN = N / BM; nwg = nM * nN; G = G_; c = c_; }
    __host__ __device__ bool next(int i, Unit& u) const {
        const long L = (long)i * G + c; if (L >= nwg) return false;
        int wgid = (int)L; { const int q = nwg / NXCD, r = nwg % NXCD, xcd = wgid % NXCD, off = wgid / NXCD; wgid = (xcd < r ? xcd * (q + 1) : r * (q + 1) + (xcd - r) * q) + off; }
        const int nig = WGM * nN, gid = wgid / nig, fm = gid * WGM, gsz = (nM - fm) < WGM ? (nM - fm) : WGM;
        u.pm = fm + ((wgid % nig) % gsz); u.pn = (wgid % nig) / gsz; return true;
    }
    __device__ __forceinline__ void a_ready(const Unit&) const {}
    __device__ __forceinline__ void done(const Unit&) const {}
};

__device__ __forceinline__ unsigned cvt_pk_bf16(float lo, float hi) { unsigned r; asm volatile("v_cvt_pk_bf16_f32 %0, %1, %2" : "=v"(r) : "v"(lo), "v"(hi)); return r; }

__device__ __forceinline__ unsigned lane_xpose(unsigned v, int src4) { return (unsigned)__builtin_amdgcn_ds_bpermute(src4, (int)v); }
__device__ __forceinline__ float lane_xposef(float v, int src4) { return __builtin_bit_cast(float, __builtin_amdgcn_ds_bpermute(src4, __builtin_bit_cast(int, v))); }
struct EpiB {
    static constexpr bool PERM = true, AFTER_DRAIN = false;
    bf16_t* O; int ldc; int split_cols; size_t split_stride;
    __device__ __forceinline__ void operator()(const f32x4 (&acc)[2][2][4][2], const Unit& u, int wr, int wc, int fr, int fq) const {
        const int L = fq * 16 + fr, Lr = L >> 2, Lq = L & 3, src4 = (16 * Lq + Lr) * 4;
        const int row0 = u.pm * BM + wr * 64 + Lr; int colt = u.pn * BM; bf16_t* base = O;
        if (split_cols) { const int t = colt / split_cols; base += (size_t)t * split_stride; colt -= t * split_cols; }
        const int col0 = colt + wc * 32 + 8 * Lq;
#pragma unroll
        for (int ai = 0; ai < 2; ++ai)
#pragma unroll
            for (int m = 0; m < 4; ++m) { bf16_t* rowp = base + (size_t)(row0 + ai * HALF + m * 16) * ldc + col0;
#pragma unroll
                for (int bj = 0; bj < 2; ++bj) { const f32x4 v0 = acc[ai][bj][m][0], v1 = acc[ai][bj][m][1];
                    u32x4 w; w.x = lane_xpose(cvt_pk_bf16(v0[0], v0[1]), src4); w.y = lane_xpose(cvt_pk_bf16(v0[2], v0[3]), src4); w.z = lane_xpose(cvt_pk_bf16(v1[0], v1[1]), src4); w.w = lane_xpose(cvt_pk_bf16(v1[2], v1[3]), src4);
                    *(u32x4*)(rowp + bj * HALF) = w; } }
    }
};
struct EpiRes {
    static constexpr bool PERM = true, AFTER_DRAIN = false;
    const float* R; float* O; int ldc;
    __device__ __forceinline__ void operator()(const f32x4 (&acc)[2][2][4][2], const Unit& u, int wr, int wc, int fr, int fq) const {
        const int L = fq * 16 + fr, Lr = L >> 2, Lq = L & 3, src4 = (16 * Lq + Lr) * 4;
        const int row0 = u.pm * BM + wr * 64 + Lr; const int col0 = u.pn * BM + wc * 32 + 8 * Lq;
#pragma unroll
        for (int ai = 0; ai < 2; ++ai)
#pragma unroll
            for (int m = 0; m < 4; ++m) { const size_t ro = (size_t)(row0 + ai * HALF + m * 16) * ldc + col0;
#pragma unroll
                for (int bj = 0; bj < 2; ++bj) { const size_t o = ro + bj * HALF;
                    const f32x4 r0 = *(const f32x4*)(R + o), r1 = *(const f32x4*)(R + o + 4);
                    const f32x4 s0 = acc[ai][bj][m][0], s1 = acc[ai][bj][m][1];
                    f32x4 a0, a1;
                    a0.x = lane_xposef(s0.x, src4); a0.y = lane_xposef(s0.y, src4); a0.z = lane_xposef(s0.z, src4); a0.w = lane_xposef(s0.w, src4);
                    a1.x = lane_xposef(s1.x, src4); a1.y = lane_xposef(s1.y, src4); a1.z = lane_xposef(s1.z, src4); a1.w = lane_xposef(s1.w, src4);
                    *(f32x4*)(O + o) = r0 + a0; *(f32x4*)(O + o + 4) = r1 + a1; } }
    }
};
struct EpiGate {
    static constexpr bool PERM = true, AFTER_DRAIN = false;
    bf16_t* O; int ldc; const bf16_t* Z; int ldz; const float* PS;
    __device__ __forceinline__ void operator()(const f32x4 (&acc)[2][2][4][2], const Unit& u, int wr, int wc, int fr, int fq) const {
        const int L = fq * 16 + fr, Lr = L >> 2, Lq = L & 3, src4 = (16 * Lq + Lr) * 4;
        const int row0 = u.pm * BM + wr * 64 + Lr; const int col0 = u.pn * BM + wc * 32 + 8 * Lq;
#pragma unroll
        for (int ai = 0; ai < 2; ++ai)
#pragma unroll
            for (int m = 0; m < 4; ++m) { const size_t row = (size_t)(row0 + ai * HALF + m * 16);
#pragma unroll
                for (int bj = 0; bj < 2; ++bj) { const int col = col0 + bj * HALF;
                    const f32x4 s0 = acc[ai][bj][m][0], s1 = acc[ai][bj][m][1];
                    const float a0 = lane_xposef(s0.x, src4), a1 = lane_xposef(s0.y, src4), a2 = lane_xposef(s0.z, src4), a3 = lane_xposef(s0.w, src4);
                    const float a4 = lane_xposef(s1.x, src4), a5 = lane_xposef(s1.y, src4), a6 = lane_xposef(s1.z, src4), a7 = lane_xposef(s1.w, src4);
                    const u32x4 z = *(const u32x4*)(Z + row * ldz + col); const f32x4 p0 = *(const f32x4*)(PS + col), p1 = *(const f32x4*)(PS + col + 4);
                    const float z0 = __builtin_bit_cast(float, z.x << 16), z1 = __builtin_bit_cast(float, z.x & 0xffff0000u), z2 = __builtin_bit_cast(float, z.y << 16), z3 = __builtin_bit_cast(float, z.y & 0xffff0000u);
                    const float z4 = __builtin_bit_cast(float, z.z << 16), z5 = __builtin_bit_cast(float, z.z & 0xffff0000u), z6 = __builtin_bit_cast(float, z.w << 16), z7 = __builtin_bit_cast(float, z.w & 0xffff0000u);
#define PG8_SILU(x) ((x) * __builtin_amdgcn_rcpf(1.f + __expf(-(x))))
                    u32x4 w; w.x = cvt_pk_bf16(a0 * p0.x * PG8_SILU(z0), a1 * p0.y * PG8_SILU(z1)); w.y = cvt_pk_bf16(a2 * p0.z * PG8_SILU(z2), a3 * p0.w * PG8_SILU(z3));
                    w.z = cvt_pk_bf16(a4 * p1.x * PG8_SILU(z4), a5 * p1.y * PG8_SILU(z5)); w.w = cvt_pk_bf16(a6 * p1.z * PG8_SILU(z6), a7 * p1.w * PG8_SILU(z7));
#undef PG8_SILU
                    *(u32x4*)(O + row * ldc + col) = w; } }
    }
};
template <class Epi, class Sched, bool ALIGN_EPI = false, bool SP2 = false>
__device__ __forceinline__ void gemm_phase(PG8_LAS unsigned char* lds, const Gemm g, const Sched& S, const Epi& E) {
    const int tid = threadIdx.x, wid = __builtin_amdgcn_readfirstlane(tid >> 6), lane = tid & 63, wr = wid >> 2, wc = wid & 3, fr = lane & 15, fq = lane >> 4;
    const int K = g.K, nt = K / BK;
    unsigned voffA[2], voffB[2];
#pragma unroll
    for (int i = 0; i < 2; ++i) { int R, C; stage_rc(tid * 16 + i * 8192, R, C); const int Rb = Epi::PERM ? ((R & ~31) + perm32(R & 31)) : R;
        voffA[i] = (unsigned)(R * K + C) * 2u; voffB[i] = (unsigned)(Rb * K + C) * 2u; }
    const size_t kstep = (size_t)(BK * 2);
    const size_t hstep = (size_t)HALF * K * 2;
    const size_t tstep = 2 * hstep;
    const unsigned ldsw = (unsigned)wid * 1024u;
    const int aoff = lds_byte(wr * 64 + fr, fq * 8), boff = lds_byte(wc * 32 + fr, fq * 8);
#define PG8_SA(b, h) (((b) * 2 + (h)) * HTB)
#define PG8_SB(b, h) ((4 + (b) * 2 + (h)) * HTB)
#define PG8_STAGE(bufoff, gbase, voff) do { _Pragma("unroll") for (int _i = 0; _i < 2; ++_i) \
        __builtin_amdgcn_global_load_lds((const unsigned*)((const char*)(gbase) + (voff)[_i]), (PG8_LAS unsigned*)(lds + (bufoff) + ldsw + _i * 8192), 16, 0, 0); } while (0)
#define PG8_LDA(dst, b, h) do { _Pragma("unroll") for (int m = 0; m < 4; ++m) _Pragma("unroll") for (int k = 0; k < 2; ++k) dst[m][k] = *(const PG8_LAS bf16x8*)(lds + PG8_SA(b, h) + aoff + m * 2048 + k * 1024); } while (0)
#define PG8_LDB(dst, b, h) do { _Pragma("unroll") for (int n = 0; n < 2; ++n) _Pragma("unroll") for (int k = 0; k < 2; ++k) dst[n][k] = *(const PG8_LAS bf16x8*)(lds + PG8_SB(b, h) + boff + n * 2048 + k * 1024); } while (0)
#define PG8_MMA(ai, bj, At, Bt) do { __builtin_amdgcn_s_setprio(1); _Pragma("unroll") for (int m = 0; m < 4; ++m) _Pragma("unroll") for (int n = 0; n < 2; ++n) _Pragma("unroll") for (int k = 0; k < 2; ++k) \
        acc[ai][bj][m][n] = __builtin_amdgcn_mfma_f32_16x16x32_bf16(Bt[n][k], At[m][k], acc[ai][bj][m][n], 0, 0, 0); __builtin_amdgcn_s_setprio(0); } while (0)
#define PG8_WAIT_V(n) asm volatile("s_waitcnt vmcnt(" #n ")" ::: "memory")
#define PG8_WAIT_L(n) asm volatile("s_waitcnt lgkmcnt(" #n ")" ::: "memory")
#define PG8_BAR __builtin_amdgcn_s_barrier()
#define PG8_SCHED __builtin_amdgcn_sched_barrier(0)
    Unit cur, nxt; int ui = 0;
    if (!S.next(0, cur)) return;
    f32x4 acc[2][2][4][2];
#pragma unroll
    for (int a = 0; a < 2; ++a)
#pragma unroll
        for (int b = 0; b < 2; ++b)
#pragma unroll
            for (int m = 0; m < 4; ++m)
#pragma unroll
                for (int n = 0; n < 2; ++n) acc[a][b][m][n] = (f32x4){0.f, 0.f, 0.f, 0.f};
    bf16x8 At[4][2], B0[2][2], B1[2][2];
    const char* cA = (const char*)g.A + (size_t)cur.pm * tstep; const char* cB = (const char*)g.Bt + (size_t)cur.pn * tstep;
    S.a_ready(cur);
    if constexpr (SP2) {
        PG8_STAGE(PG8_SB(0, 0), cB, voffB); PG8_STAGE(PG8_SB(0, 1), cB + hstep, voffB); PG8_STAGE(PG8_SA(0, 0), cA, voffA); PG8_STAGE(PG8_SA(0, 1), cA + hstep, voffA);
        if (wr == 1) PG8_BAR;
        PG8_WAIT_V(2); PG8_BAR;
        PG8_STAGE(PG8_SB(1, 0), cB + kstep, voffB); PG8_STAGE(PG8_SA(1, 0), cA + kstep, voffA); PG8_STAGE(PG8_SB(1, 1), cB + hstep + kstep, voffB);
        PG8_WAIT_V(6); PG8_BAR;
    } else {
        PG8_STAGE(PG8_SB(0, 0), cB, voffB); PG8_STAGE(PG8_SA(0, 0), cA, voffA); PG8_STAGE(PG8_SB(0, 1), cB + hstep, voffB); PG8_STAGE(PG8_SA(0, 1), cA + hstep, voffA);
        if (wr == 1) PG8_BAR;
        PG8_WAIT_V(4); PG8_BAR;
        PG8_STAGE(PG8_SB(1, 0), cB + kstep, voffB); PG8_STAGE(PG8_SA(1, 0), cA + kstep, voffA); PG8_STAGE(PG8_SB(1, 1), cB + hstep + kstep, voffB);
        PG8_WAIT_V(6); PG8_BAR;
    }
    for (;;) {
        const bool has_next = S.next(ui + 1, nxt);
        const char* nA = has_next ? (const char*)g.A + (size_t)nxt.pm * tstep : cA; const char* nB = has_next ? (const char*)g.Bt + (size_t)nxt.pn * tstep : cB;
        for (int t = 0; t < nt; t += 2) {
            const bool last = (t == nt - 2);
            const char* a1 = cA + (size_t)(t + 1) * kstep;
            const char* a2 = last ? nA : cA + (size_t)(t + 2) * kstep; const char* b2 = last ? nB : cB + (size_t)(t + 2) * kstep;
            const char* a3 = a2 + kstep; const char* b3 = b2 + kstep;
            if (last && has_next) S.a_ready(nxt);
            if constexpr (SP2) {
            PG8_LDB(B0, 0, 0); PG8_LDB(B1, 0, 1); PG8_SCHED; PG8_LDA(At, 0, 0); PG8_STAGE(PG8_SA(1, 1), a1 + hstep, voffA);
            PG8_WAIT_V(8); PG8_WAIT_L(0); PG8_BAR; PG8_MMA(0, 0, At, B0); PG8_MMA(0, 1, At, B1); PG8_BAR; PG8_SCHED;
            PG8_LDA(At, 0, 1); PG8_STAGE(PG8_SB(0, 0), b2, voffB); PG8_STAGE(PG8_SB(0, 1), b2 + hstep, voffB); PG8_STAGE(PG8_SA(0, 0), a2, voffA);
            PG8_WAIT_V(8); PG8_WAIT_L(0); PG8_BAR; PG8_MMA(1, 0, At, B0); PG8_MMA(1, 1, At, B1); PG8_BAR; PG8_SCHED;
            PG8_LDB(B0, 1, 0); PG8_LDB(B1, 1, 1); PG8_SCHED; PG8_LDA(At, 1, 0); PG8_STAGE(PG8_SA(0, 1), a2 + hstep, voffA);
            PG8_WAIT_V(8); PG8_WAIT_L(0); PG8_BAR; PG8_MMA(0, 0, At, B0); PG8_MMA(0, 1, At, B1); PG8_BAR; PG8_SCHED;
            PG8_LDA(At, 1, 1); PG8_STAGE(PG8_SB(1, 0), b3, voffB); PG8_STAGE(PG8_SB(1, 1), b3 + hstep, voffB); PG8_STAGE(PG8_SA(1, 0), a3, voffA);
            PG8_WAIT_V(8); PG8_WAIT_L(0); PG8_BAR; PG8_MMA(1, 0, At, B0); PG8_MMA(1, 1, At, B1); PG8_BAR; PG8_SCHED;
            } else {
            PG8_LDB(B0, 0, 0); PG8_SCHED; PG8_LDA(At, 0, 0); PG8_STAGE(PG8_SA(1, 1), a1 + hstep, voffA);
            PG8_WAIT_L(8); PG8_BAR; PG8_WAIT_L(0); PG8_MMA(0, 0, At, B0); PG8_BAR; PG8_SCHED;
            PG8_LDB(B1, 0, 1); PG8_STAGE(PG8_SB(0, 0), b2, voffB);
            PG8_BAR; PG8_WAIT_L(0); PG8_MMA(0, 1, At, B1); PG8_BAR;
            PG8_LDA(At, 0, 1); PG8_STAGE(PG8_SA(0, 0), a2, voffA);
            PG8_BAR; PG8_WAIT_L(0); PG8_MMA(1, 0, At, B0); PG8_BAR; PG8_SCHED;
            PG8_STAGE(PG8_SB(0, 1), b2 + hstep, voffB);
            PG8_WAIT_V(6); PG8_BAR; PG8_MMA(1, 1, At, B1); PG8_BAR;
            PG8_LDB(B0, 1, 0); PG8_SCHED; PG8_LDA(At, 1, 0); PG8_STAGE(PG8_SA(0, 1), a2 + hstep, voffA);
            PG8_WAIT_L(8); PG8_BAR; PG8_WAIT_L(0); PG8_MMA(0, 0, At, B0); PG8_BAR; PG8_SCHED;
            PG8_LDB(B1, 1, 1); PG8_STAGE(PG8_SB(1, 0), b3, voffB);
            PG8_BAR; PG8_WAIT_L(0); PG8_MMA(0, 1, At, B1); PG8_BAR;
            PG8_LDA(At, 1, 1); PG8_STAGE(PG8_SA(1, 0), a3, voffA);
            PG8_BAR; PG8_WAIT_L(0); PG8_MMA(1, 0, At, B0); PG8_BAR; PG8_SCHED;
            PG8_STAGE(PG8_SB(1, 1), b3 + hstep, voffB);
            PG8_WAIT_V(6); PG8_BAR; PG8_MMA(1, 1, At, B1); PG8_BAR;
            }
        }
        if constexpr (ALIGN_EPI) { if (wr == 0) PG8_BAR; }
        if constexpr (!Epi::AFTER_DRAIN) { E(acc, cur, wr, wc, fr, fq); S.done(cur); }
        if (!has_next) break;
#pragma unroll
        for (int a = 0; a < 2; ++a)
#pragma unroll
            for (int b = 0; b < 2; ++b)
#pragma unroll
                for (int m = 0; m < 4; ++m)
#pragma unroll
                    for (int n = 0; n < 2; ++n) acc[a][b][m][n] = (f32x4){0.f, 0.f, 0.f, 0.f};
        cur = nxt; cA = nA; cB = nB; ++ui;
        if constexpr (ALIGN_EPI) { if (wr == 1) PG8_BAR; }
    }
    PG8_WAIT_V(0);
    if constexpr (!ALIGN_EPI) { if (wr == 0) PG8_BAR; }
    PG8_BAR;
    if constexpr (Epi::AFTER_DRAIN) { E.fused(acc, cur, wr, wc, fr, fq, lds, wid, lane); S.done(cur); }
#undef PG8_SA
#undef PG8_SB
#undef PG8_STAGE
#undef PG8_LDA
#undef PG8_LDB
#undef PG8_MMA
#undef PG8_WAIT_V
#undef PG8_WAIT_L
#undef PG8_BAR
#undef PG8_SCHED
}
}

#define LAS __attribute__((address_space(3)))
typedef unsigned short bf16;
typedef unsigned v4u __attribute__((ext_vector_type(4)));
typedef unsigned v2u __attribute__((ext_vector_type(2)));
typedef float f32x4 __attribute__((ext_vector_type(4)));
typedef float f32x16 __attribute__((ext_vector_type(16)));
typedef short bf16x8 __attribute__((ext_vector_type(8)));
typedef short s16x4 __attribute__((ext_vector_type(4)));
#define LDS_WAIT() asm volatile("s_waitcnt lgkmcnt(0)" ::: "memory")

constexpr int T_ = 32768, S_ = 8192, D_ = 1024, NW = 8, NTHR = 512;
constexpr size_t MiB = 1u << 20, REG = 64 * MiB;
constexpr size_t RGN(int i) { return (size_t)i * REG; }
constexpr size_t MISC = 7 * REG;
constexpr size_t O_WIN0 = MISC + 0 * MiB, O_WQKV = MISC + 4 * MiB, O_WPOOL = MISC + 6 * MiB, O_WOUTAB = MISC + 7 * MiB, O_WINC = MISC + 9 * MiB, O_WOUTC = MISC + 17 * MiB,
                 O_ROPE = MISC + 19 * MiB, O_G = MISC + 23 * MiB, O_BETA = MISC + 24 * MiB, O_GL = MISC + 25 * MiB, O_BAR = MISC + 26 * MiB, WS_NEED = MISC + 27 * MiB;
constexpr int LDS_BYTES = 147456;
constexpr int P0LD = 2176;
constexpr size_t O_QKV = 3 * REG + 16 * MiB;
constexpr float EPS = 1e-6f;

__device__ __forceinline__ float bflo(unsigned u) { return __builtin_bit_cast(float, u << 16); }
__device__ __forceinline__ float bfhi(unsigned u) { return __builtin_bit_cast(float, u & 0xffff0000u); }
__device__ __forceinline__ float bf1(bf16 b) { return __builtin_bit_cast(float, (unsigned)b << 16); }
__device__ __forceinline__ unsigned f2bf(float f) { unsigned u = __builtin_bit_cast(unsigned, f); return (u + 0x7fffu + ((u >> 16) & 1u)) >> 16; }
typedef __bf16 hwbf16x2 __attribute__((ext_vector_type(2)));
typedef float f32x2v __attribute__((ext_vector_type(2)));
__device__ __forceinline__ unsigned pk2(float lo, float hi) { const f32x2v v = {lo, hi}; return __builtin_bit_cast(unsigned, __builtin_convertvector(v, hwbf16x2)); }
__device__ __forceinline__ float row16_sum(float v) {
    v += __builtin_bit_cast(float, __builtin_amdgcn_update_dpp(0, __builtin_bit_cast(int, v), 0x128, 0xf, 0xf, false));
    v += __builtin_bit_cast(float, __builtin_amdgcn_update_dpp(0, __builtin_bit_cast(int, v), 0x124, 0xf, 0xf, false));
    v += __builtin_bit_cast(float, __builtin_amdgcn_update_dpp(0, __builtin_bit_cast(int, v), 0x122, 0xf, 0xf, false));
    v += __builtin_bit_cast(float, __builtin_amdgcn_update_dpp(0, __builtin_bit_cast(int, v), 0x121, 0xf, 0xf, false));
    return v;
}
__device__ __forceinline__ float wave_sum(float v) { v = row16_sum(v); v += __shfl_xor(v, 16); v += __shfl_xor(v, 32); return v; }
__device__ __forceinline__ float silu(float z) { return z * __builtin_amdgcn_rcpf(1.f + __expf(-z)); }


struct Args { const void* in[19]; float* out; unsigned char* ws; float inv_freq[16]; int ph_lo, ph_hi, dry, pad; };

__device__ __forceinline__ void transpose_item(const float* W, int ldw, bf16* WT, int ldt, int k0, int n0, int trow0, int tcol0, LAS float* scr, int lane) {
#pragma unroll 8
    for (int i = 0; i < 32; ++i) { const int kk = 2 * i + (lane >> 5); scr[kk * 33 + (lane & 31)] = __builtin_nontemporal_load(W + (size_t)(k0 + kk) * ldw + n0 + (lane & 31)); }
    LDS_WAIT();
    const int c = lane & 7;
#pragma unroll
    for (int j = 0; j < 4; ++j) { const int n = (lane >> 3) + 8 * j; const LAS float* s = scr + (8 * c) * 33 + n;
        v4u o; o.x = pk2(s[0 * 33], s[1 * 33]); o.y = pk2(s[2 * 33], s[3 * 33]); o.z = pk2(s[4 * 33], s[5 * 33]); o.w = pk2(s[6 * 33], s[7 * 33]);
        *(v4u*)(WT + (size_t)(trow0 + n) * ldt + tcol0 + 8 * c) = o; }
    LDS_WAIT();
}
__device__ __forceinline__ void transpose_job(const float* W, int ldw, int Nuse, bf16* WT, int ldt, int n_off, int k_off, int item, LAS float* scr, int lane) {
    const int nblk = Nuse / 32, kb = item / nblk, nb = item % nblk;
    transpose_item(W, ldw, WT, ldt, 64 * kb, 32 * nb, n_off + 32 * nb, k_off + 64 * kb, scr, lane);
}

__device__ __forceinline__ void p0_prologue(const Args& a, LAS unsigned char* lds) {
    const int tid = threadIdx.x, lane = tid & 63, wave = tid >> 6;
    const int gw = blockIdx.x * NW + wave, NGW = gridDim.x * NW;
    unsigned char* ws = a.ws;
    LAS float* scr = (LAS float*)(lds + wave * 16384);
    bf16* WIN0 = (bf16*)(ws + O_WIN0); bf16* WQKV = (bf16*)(ws + O_WQKV); bf16* WPOOL = (bf16*)(ws + O_WPOOL); bf16* WOUTAB = (bf16*)(ws + O_WOUTAB);
    bf16* WINC = (bf16*)(ws + O_WINC); bf16* WOUTC = (bf16*)(ws + O_WOUTC);
    constexpr int I0 = 16 * 61, I1 = 4 * 24, I2 = 2 * 32, I3 = 4 * 8, I4 = 16 * 32, I5 = 16 * 128, I6 = 16 * 32, NIT = I0 + I1 + I2 + I3 + I4 + I5 + I6;
    for (int it = gw; it < NIT; it += NGW) {
        int r = it;
        if (r < I0) { transpose_job((const float*)a.in[3], 1952, 1952, WIN0, 1024, 0, 0, r, scr, lane); continue; } r -= I0;
        if (r < I1) { transpose_job((const float*)a.in[5], 768, 768, WQKV, 384, 0, 0, r, scr, lane); continue; } r -= I1;
        if (r < I2) { transpose_job((const float*)a.in[7], 1024, 1024, WQKV, 384, 768, 256, r, scr, lane); continue; } r -= I2;
        if (r < I3) { const int g = r >> 3; transpose_job((const float*)a.in[8] + (size_t)g * 128 * 128, 128, 128, WPOOL, 512, g * 128, g * 128, r & 7, scr, lane); continue; } r -= I3;
        if (r < I4) { transpose_job((const float*)a.in[10], 1024, 1024, WOUTAB, 1024, 0, 0, r, scr, lane); continue; } r -= I4;
        if (r < I5) { transpose_job((const float*)a.in[12], 4112, 4096, WINC, 1024, 0, 0, r, scr, lane); continue; } r -= I5;
        transpose_job((const float*)a.in[17], 1024, 1024, WOUTC, 1024, 0, 0, r, scr, lane);
    }
    const int gt = blockIdx.x * NTHR + tid, NGT = gridDim.x * NTHR;
    const v4u z4 = {0u, 0u, 0u, 0u};
    for (int i = gt; i < 96 * 128; i += NGT) *(v4u*)(WIN0 + (size_t)1952 * 1024 + (size_t)i * 8) = z4;
    for (int i = gt; i < 1792 * 48; i += NGT) { const int row = i / 48, c8 = (i % 48) * 8; const bool isq = row < 768; const bool zero = isq ? (c8 >= 256) : (c8 < 256); if (zero) *(v4u*)(WQKV + (size_t)row * 384 + c8) = z4; }
    for (int i = gt; i < 512 * 64; i += NGT) { const int row = i / 64, c8 = (i % 64) * 8; if ((row >> 7) != (c8 >> 7)) *(v4u*)(WPOOL + (size_t)row * 512 + c8) = z4; }
    { float2* rope = (float2*)(ws + O_ROPE); const int* pos = (const int*)a.in[1];
      for (int i = gt; i < T_ * 16; i += NGT) { const int t = i >> 4, f = i & 15; const float ang = (float)pos[t] * a.inv_freq[f];
          const float C_HI = 0.15915494f, C_LO = 3.0908620e-9f;
          const float rev = ang * C_HI; const float err = fmaf(ang, C_HI, -rev) + ang * C_LO; const float fr = (rev - rintf(rev)) + err;
          rope[i] = make_float2(__builtin_amdgcn_cosf(fr), __builtin_amdgcn_sinf(fr)); } }
    { const float* x = (const float*)a.in[0]; const float* g = (const float*)a.in[2]; bf16* XN = (bf16*)(ws + RGN(0));
      f32x4 gv[4];
#pragma unroll
      for (int j = 0; j < 4; ++j) gv[j] = *(const f32x4*)(g + 4 * lane + 256 * j);
      f32x4 nv[4];
      { const f32x4* xr = (const f32x4*)(x + (size_t)(gw < T_ ? gw : 0) * D_) + lane;
#pragma unroll
        for (int j = 0; j < 4; ++j) nv[j] = __builtin_nontemporal_load(xr + 64 * j); }
      for (int m = gw; m < T_; m += NGW) {
          f32x4 v[4]; float s = 0.f;
          { const int mn = (m + NGW < T_) ? m + NGW : m; const f32x4* xn = (const f32x4*)(x + (size_t)mn * D_) + lane;
#pragma unroll
            for (int j = 0; j < 4; ++j) { v[j] = nv[j]; nv[j] = __builtin_nontemporal_load(xn + 64 * j); } }
#pragma unroll
          for (int j = 0; j < 4; ++j) s += (v[j].x * v[j].x + v[j].y * v[j].y) + (v[j].z * v[j].z + v[j].w * v[j].w);
          const float rs = rsqrtf(wave_sum(s) * (1.f / D_) + EPS);
          v2u* o8 = (v2u*)(XN + (size_t)m * D_) + lane;
#pragma unroll
          for (int j = 0; j < 4; ++j) { v2u o; o.x = pk2(v[j].x * rs * gv[j].x, v[j].y * rs * gv[j].y); o.y = pk2(v[j].z * rs * gv[j].z, v[j].w * rs * gv[j].w); o8[64 * j] = o; }
      } }
}

__device__ __forceinline__ void p2_prep(const Args& a) {
    const int tid = threadIdx.x, lane = tid & 63, wave = tid >> 6;
    const int gw = blockIdx.x * NW + wave, NGW = gridDim.x * NW;
    unsigned char* ws = a.ws;
    const bf16* proj0 = (const bf16*)(ws + RGN(1));
    bf16* A2 = (bf16*)(ws + RGN(5)); bf16* KR = (bf16*)(ws + RGN(5) + 24 * MiB); bf16* DP = (bf16*)(ws + RGN(5) + 26 * MiB);
    const float2* rope = (const float2*)(ws + O_ROPE);
    const f32x4 qg = *(const f32x4*)((const float*)a.in[4] + 4 * lane);
    const float2 kg = *(const float2*)((const float*)a.in[6] + 2 * lane);
    for (int t = gw; t < T_; t += NGW) {
        const bf16* pr = proj0 + (size_t)t * P0LD;
        { const v2u q = *(const v2u*)(pr + 4 * lane); const float q0 = bflo(q.x), q1 = bfhi(q.x), q2 = bflo(q.y), q3 = bfhi(q.y);
          const float rs = rsqrtf(wave_sum((q0 * q0 + q1 * q1) + (q2 * q2 + q3 * q3)) * (1.f / 256.f) + EPS);
          v2u o; o.x = pk2(q0 * rs * qg.x, q1 * rs * qg.y); o.y = pk2(q2 * rs * qg.z, q3 * rs * qg.w); *(v2u*)(A2 + (size_t)t * 384 + 4 * lane) = o; }
        { const unsigned k = *(const unsigned*)(pr + 256 + 2 * lane); const float k0 = bflo(k), k1 = bfhi(k);
          const float rs = rsqrtf(wave_sum(k0 * k0 + k1 * k1) * (1.f / 128.f) + EPS);
          *(unsigned*)(A2 + (size_t)t * 384 + 256 + 2 * lane) = pk2(k0 * rs * kg.x, k1 * rs * kg.y); }
        if (lane < 16) { const float x1 = bf1(pr[384 + lane]), x2 = bf1(pr[400 + lane]); const float2 cs = rope[(size_t)t * 16 + lane];
          *(unsigned*)(KR + (size_t)t * 32 + 2 * lane) = pk2(x1 * cs.x - x2 * cs.y, x2 * cs.x + x1 * cs.y); }
        { const int g = lane >> 4, w = 2 << g, ts = t & (S_ - 1), cnt = min(ts + 1, w);
          float acc[8];
#pragma unroll
          for (int e = 0; e < 8; ++e) acc[e] = 0.f;
          v4u wv[16];
#pragma unroll
          for (int j = 0; j < 16; ++j) { const int jj = (j < cnt) ? j : 0; wv[j] = *(const v4u*)(pr - (size_t)jj * P0LD + 416 + 8 * lane); }
          float x0[8];
#pragma unroll
          for (int j = 0; j < 16; ++j) { const v4u v = wv[j]; const float mk = (j < cnt) ? 1.f : 0.f;
              const float f[8] = {bflo(v.x), bfhi(v.x), bflo(v.y), bfhi(v.y), bflo(v.z), bfhi(v.z), bflo(v.w), bfhi(v.w)};
#pragma unroll
              for (int e = 0; e < 8; ++e) { acc[e] = fmaf(f[e], mk, acc[e]); if (j == 0) x0[e] = f[e]; }
          }
          const float ic = 1.f / (float)cnt; v4u o;
          o.x = pk2(acc[0] * ic - x0[0], acc[1] * ic - x0[1]); o.y = pk2(acc[2] * ic - x0[2], acc[3] * ic - x0[3]);
          o.z = pk2(acc[4] * ic - x0[4], acc[5] * ic - x0[5]); o.w = pk2(acc[6] * ic - x0[6], acc[7] * ic - x0[7]);
          *(v4u*)(DP + (size_t)t * 512 + 8 * lane) = o; }
    }
}

constexpr int KROW = 208, KBYTES = 64 * KROW, VBYTES = 8192;
typedef short v4i16_t __attribute__((ext_vector_type(4)));
__device__ __forceinline__ s16x4 vtr(const LAS unsigned char* p) { return __builtin_bit_cast(s16x4, __builtin_amdgcn_ds_read_tr16_b64_v4i16((LAS v4i16_t*)p)); }
__device__ __forceinline__ bf16x8 cat8(s16x4 lo, s16x4 hi) { bf16x8 r; r[0] = lo[0]; r[1] = lo[1]; r[2] = lo[2]; r[3] = lo[3]; r[4] = hi[0]; r[5] = hi[1]; r[6] = hi[2]; r[7] = hi[3]; return r; }
__device__ __forceinline__ bf16x8 pack8(float a0, float a1, float a2, float a3, float a4, float a5, float a6, float a7) {
    v4u u; u.x = pk2(a0, a1); u.y = pk2(a2, a3); u.z = pk2(a4, a5); u.w = pk2(a6, a7); return __builtin_bit_cast(bf16x8, u); }

__device__ __forceinline__ void attn_unit(LAS unsigned char* lds, int b, int h, int qb, const bf16* qkv, const bf16* KR, const float2* rope, const bf16* proj0, bf16* Y) {
    int tid = threadIdx.x; asm volatile("" : "+v"(tid));
    const int lane = tid & 63, wave = __builtin_amdgcn_readfirstlane(tid >> 6), r = lane & 31, hh = lane >> 5;
    const int q0 = qb * 256, myq = q0 + 32 * wave + r;
    const size_t tq = (size_t)b * S_ + myq;
    const float CS = 0.10206207261596577f * 1.4426950408889634f;
    bf16x8 Qf[6];
    { const bf16* qp = qkv + tq * 1792 + h * 96;
#pragma unroll
      for (int s = 0; s < 4; ++s) Qf[s] = *(const bf16x8*)(qp + 16 * s + 8 * hh);
#pragma unroll
      for (int s2 = 0; s2 < 2; ++s2) { const int i0 = 8 * s2 + 4 * hh;
          const v2u xa = *(const v2u*)(qp + 64 + i0), xb = *(const v2u*)(qp + 80 + i0);
          const f32x4 c0 = *(const f32x4*)(rope + tq * 16 + i0), c1 = *(const f32x4*)(rope + tq * 16 + i0 + 2);
          const float a0 = bflo(xa.x), a1 = bfhi(xa.x), a2 = bflo(xa.y), a3 = bfhi(xa.y), b0 = bflo(xb.x), b1 = bfhi(xb.x), b2 = bflo(xb.y), b3 = bfhi(xb.y);
          Qf[4 + s2] = pack8(a0 * c0.x - b0 * c0.y, b0 * c0.x + a0 * c0.y, a1 * c0.z - b1 * c0.w, b1 * c0.z + a1 * c0.w,
                             a2 * c1.x - b2 * c1.y, b2 * c1.x + a2 * c1.y, a3 * c1.z - b3 * c1.w, b3 * c1.z + a3 * c1.w); } }
    const int skey = tid >> 3, sch = tid & 7, rkey = tid >> 2, rch = tid & 3;
    const bf16* kvbase = qkv + ((size_t)b * S_) * 1792 + 768 + h * 128;
    const bf16* krbase = KR + ((size_t)b * S_) * 32;
    constexpr int KB2 = 128 * KROW, VB2 = 2 * VBYTES, VOFF = 2 * KB2;
    const int NT = 2 * (qb + 1);
    const int qhi = q0 + 32 * wave + 31, qlo = q0 + 32 * wave;
    v4u gk0, gk1, gr, gv0, gv1;
#define ATT_LDK(T_) do { const size_t kk_ = (size_t)(T_) * 128; \
        gk0 = *(const v4u*)(kvbase + (kk_ + skey) * 1792 + sch * 8); gk1 = *(const v4u*)(kvbase + (kk_ + 64 + skey) * 1792 + sch * 8); \
        gr = *(const v4u*)(krbase + (kk_ + rkey) * 32 + rch * 8); } while (0)
#define ATT_LDV(T_) do { const size_t kk_ = (size_t)(T_) * 128; \
        gv0 = *(const v4u*)(kvbase + (kk_ + skey) * 1792 + 64 + sch * 8); gv1 = *(const v4u*)(kvbase + (kk_ + 64 + skey) * 1792 + 64 + sch * 8); } while (0)
#define ATT_LD(T_) do { ATT_LDK(T_); ATT_LDV(T_); } while (0)
#define ATT_STK(buf) do { LAS unsigned char* Kn_ = lds + (buf) * KB2; \
        *(LAS v4u*)(Kn_ + skey * KROW + sch * 16) = gk0; *(LAS v4u*)(Kn_ + (64 + skey) * KROW + sch * 16) = gk1; *(LAS v4u*)(Kn_ + rkey * KROW + 128 + rch * 16) = gr; } while (0)
#define ATT_STV(buf) do { LAS unsigned char* Vn_ = lds + VOFF + (buf) * VB2; \
        *(LAS v4u*)(Vn_ + (sch >> 2) * 4096 + skey * 64 + (sch & 3) * 16) = gv0; *(LAS v4u*)(Vn_ + VBYTES + (sch >> 2) * 4096 + skey * 64 + (sch & 3) * 16) = gv1; } while (0)
#define ATT_ST(buf) do { ATT_STK(buf); ATT_STV(buf); } while (0)
#define ATT_QK(dst0, dst1, Kb_) do { \
        _Pragma("unroll") for (int i_ = 0; i_ < 16; ++i_) { dst0[i_] = 0.f; dst1[i_] = 0.f; } \
        _Pragma("unroll") for (int s_ = 0; s_ < 6; ++s_) { \
            const bf16x8 ka_ = *(const LAS bf16x8*)((Kb_) + r * KROW + (16 * s_ + 8 * hh) * 2); const bf16x8 kb_ = *(const LAS bf16x8*)((Kb_) + (32 + r) * KROW + (16 * s_ + 8 * hh) * 2); \
            dst0 = __builtin_amdgcn_mfma_f32_32x32x16_bf16(ka_, Qf[s_], dst0, 0, 0, 0); dst1 = __builtin_amdgcn_mfma_f32_32x32x16_bf16(kb_, Qf[s_], dst1, 0, 0, 0); } } while (0)
#define ATT_SMPV(s0, s1, kbase_, Vb_, GEN, FIRST) do { \
        if (GEN) { \
            if ((kbase_) + 63 > qlo) { \
                _Pragma("unroll") for (int i = 0; i < 16; ++i) { const int key = (kbase_) + 8 * (i >> 2) + 4 * hh + (i & 3); \
                    if (key > myq) s0[i] = -INFINITY; if (key + 32 > myq) s1[i] = -INFINITY; } } \
            if (FIRST) { float mx = fmaxf(s0[0], s1[0]); \
                _Pragma("unroll") for (int i = 1; i < 16; ++i) mx = fmaxf(mx, fmaxf(s0[i], s1[i])); \
                m_run = fmaxf(mx, __shfl_xor(mx, 32)); } \
        } \
        const float nm = -m_run * CS; float ps = 0.f; \
        _Pragma("unroll") for (int i = 0; i < 16; ++i) { s0[i] = __builtin_amdgcn_exp2f(fmaf(s0[i], CS, nm)); s1[i] = __builtin_amdgcn_exp2f(fmaf(s1[i], CS, nm)); ps += s0[i] + s1[i]; } \
        l_run += ps; \
        const bf16x8 P00 = pack8(s0[0], s0[1], s0[2], s0[3], s0[4], s0[5], s0[6], s0[7]); \
        const bf16x8 P01 = pack8(s0[8], s0[9], s0[10], s0[11], s0[12], s0[13], s0[14], s0[15]); \
        const bf16x8 P10 = pack8(s1[0], s1[1], s1[2], s1[3], s1[4], s1[5], s1[6], s1[7]); \
        const bf16x8 P11 = pack8(s1[8], s1[9], s1[10], s1[11], s1[12], s1[13], s1[14], s1[15]); \
        _Pragma("unroll") for (int ks = 0; ks < 4; ++ks) { \
            const bf16x8 P = ks == 0 ? P00 : ks == 1 ? P01 : ks == 2 ? P10 : P11; \
            const LAS unsigned char* vp = (Vb_) + (16 * ks) * 64 + troff; \
            const bf16x8 va0 = cat8(vtr(vp), vtr(vp + 8 * 64)); \
            const bf16x8 va1 = cat8(vtr(vp + 4096), vtr(vp + 4096 + 8 * 64)); \
            o0 = __builtin_amdgcn_mfma_f32_32x32x16_bf16(va0, P, o0, 0, 0, 0); \
            o1 = __builtin_amdgcn_mfma_f32_32x32x16_bf16(va1, P, o1, 0, 0, 0); } } while (0)
#define ATT_ITER(GEN) do { \
        const int kb0 = T * 128; \
        const int Tn = T + 1 < NT ? T + 1 : T; ATT_LDK(Tn); \
        const LAS unsigned char* Kb = lds + (T & 1) * KB2; const LAS unsigned char* Vb = lds + VOFF + (T & 1) * VB2; \
        const bool actA = !(GEN) || (kb0 <= qhi), actB = !(GEN) || (kb0 + 64 <= qhi); \
        if (actA) ATT_QK(a0, a1, Kb); \
        if (actB) ATT_QK(b0, b1, Kb + 64 * KROW); \
        ATT_STK((T + 1) & 1); ATT_LDV(Tn); \
        if (actA) ATT_SMPV(a0, a1, kb0, Vb, GEN, T == 0); \
        if (actB) ATT_SMPV(b0, b1, kb0 + 64, Vb + VBYTES, GEN, false); \
        ATT_STV((T + 1) & 1); \
        __syncthreads(); } while (0)
    f32x16 o0, o1, a0, a1, b0, b1; float m_run = -INFINITY, l_run = 0.f;
#pragma unroll
    for (int i = 0; i < 16; ++i) { o0[i] = 0.f; o1[i] = 0.f; }
    const int g4 = lane >> 4, tq_ = (lane & 15) >> 2, tp = lane & 3;
    const int troff = (4 * hh + tq_) * 64 + (16 * (g4 & 1) + 4 * tp) * 2;
    ATT_LD(0); ATT_ST(0);
    __syncthreads();
    int T = 0;
    ATT_ITER(true);
    for (T = 1; T < 2 * qb; ++T) ATT_ITER(false);
    for (; T < NT; ++T) ATT_ITER(true);
#undef ATT_LD
#undef ATT_LDK
#undef ATT_LDV
#undef ATT_ST
#undef ATT_STK
#undef ATT_STV
#undef ATT_QK
#undef ATT_SMPV
#undef ATT_ITER
    const float lt = l_run + __shfl_xor(l_run, 32), inv = 1.f / lt;
    const bf16* zp = proj0 + tq * P0LD + 928 + h * 64; bf16* yp = Y + tq * 1024 + h * 64;
#pragma unroll
    for (int c = 0; c < 2; ++c)
#pragma unroll
        for (int gq = 0; gq < 4; ++gq) { const int dv = 32 * c + 8 * gq + 4 * hh;
            const v2u z = *(const v2u*)(zp + dv);
            const float v0 = (c ? o1[4 * gq + 0] : o0[4 * gq + 0]) * inv, v1 = (c ? o1[4 * gq + 1] : o0[4 * gq + 1]) * inv, v2 = (c ? o1[4 * gq + 2] : o0[4 * gq + 2]) * inv, v3 = (c ? o1[4 * gq + 3] : o0[4 * gq + 3]) * inv;
            v2u o; o.x = pk2(v0 * silu(bflo(z.x)), v1 * silu(bfhi(z.x))); o.y = pk2(v2 * silu(bflo(z.y)), v3 * silu(bfhi(z.y)));
            *(v2u*)(yp + dv) = o; }
}

__device__ __forceinline__ void p4_attn(const Args& a, LAS unsigned char* lds) {
    unsigned char* ws = a.ws;
    const bf16* proj0 = (const bf16*)(ws + RGN(1)); const bf16* qkv = (const bf16*)(ws + O_QKV); const bf16* KR = (const bf16*)(ws + RGN(5) + 24 * MiB);
    const bf16* YB = (const bf16*)(ws + RGN(6)); bf16* Y = (bf16*)(ws + RGN(0)); const float2* rope = (const float2*)(ws + O_ROPE);
    for (int it = blockIdx.x; it < 512; it += gridDim.x) {
        const int xcd = it & 7, j = it >> 3, bh = xcd * 4 + (j & 3), pr = j >> 2, b = bh >> 3, h = bh & 7;
#pragma unroll 1
        for (int u = 0; u < 2; ++u) attn_unit(lds, b, h, u ? 31 - pr : pr, qkv, KR, rope, proj0, Y);
    }
}

#define XB_TMO      128
#define XB_XCNT(j)  (256  + 64 * (j))
#define XB_XSUB(j)  (1280 + 64 * (j))
#define XB_XGEN(j)  (2304 + 64 * (j))
#define XB_TOP      3328
#define XB_TOPGEN   3392
#define XCD_BAR_WORDS 3456
#define XB_SPIN_CAP (1u << 18)

__device__ __forceinline__ unsigned xb_ld(unsigned* p)              { return __hip_atomic_load(p, __ATOMIC_RELAXED, __HIP_MEMORY_SCOPE_AGENT); }
__device__ __forceinline__ unsigned xb_add(unsigned* p, unsigned v) { return __hip_atomic_fetch_add(p, v, __ATOMIC_RELAXED, __HIP_MEMORY_SCOPE_AGENT); }
__device__ __forceinline__ unsigned xb_xcc_id() { return (unsigned)__builtin_amdgcn_s_getreg((3 << 11) | 20) & 0xFu; }
#define XB_SPIN(cond, bar) do { unsigned _sp = 0; while (cond) { __builtin_amdgcn_s_sleep(1); \
    if ((++_sp & 255u) == 0u) { if (xb_ld(&(bar)[XB_TMO])) break; if (_sp > XB_SPIN_CAP) { atomicAdd(&(bar)[XB_TMO], 1u); break; } } } } while (0)

struct XcdBarrier {
    unsigned* bar; unsigned x;
    volatile LAS unsigned* st;
};

__device__ __forceinline__ XcdBarrier xcd_barrier_post(unsigned* bar, volatile LAS unsigned* st) {
    XcdBarrier b; b.bar = bar; b.x = xb_xcc_id(); b.st = st;
    if (threadIdx.x == 0) (void)xb_add(&bar[XB_XCNT(b.x)], 1u);
    return b;
}
__device__ __forceinline__ void xcd_barrier_complete(unsigned* bar, unsigned x, unsigned& nloc, unsigned& nx) {
    const unsigned G = gridDim.x * gridDim.y * gridDim.z;
    unsigned sum, cnt, mine, sp = 0u;
    for (;;) {
        sum = 0u; cnt = 0u; mine = 0u;
#pragma unroll
        for (unsigned j = 0; j < 16; ++j) { const unsigned c = xb_ld(&bar[XB_XCNT(j)]); sum += c; cnt += (c > 0u) ? 1u : 0u; mine = (j == x) ? c : mine; }
        if (sum == G) break;
        __builtin_amdgcn_s_sleep(1);
        if ((++sp & 255u) == 0u) { if (xb_ld(&bar[XB_TMO])) break; if (sp > XB_SPIN_CAP) { atomicAdd(&bar[XB_TMO], 1u); break; } }
    }
    nloc = mine > 0u ? mine : 1u; nx = cnt > 0u ? cnt : 1u;
}

__device__ __forceinline__ void xcd_barrier(const XcdBarrier& b) {
    asm volatile("s_waitcnt vmcnt(0)" ::: "memory");
    __syncthreads();
    if (threadIdx.x == 0) {
        unsigned* bar = b.bar;
        __builtin_amdgcn_s_waitcnt(0);
        unsigned nloc = b.st[0], nx = b.st[1];
        if (nloc == 0u) { xcd_barrier_complete(bar, b.x, nloc, nx); b.st[0] = nloc; b.st[1] = nx; }
        const unsigned old = xb_add(&bar[XB_XSUB(b.x)], 1u);
        const unsigned gen = old / nloc;
        if (old + 1u == (gen + 1u) * nloc) {
            __builtin_amdgcn_fence(__ATOMIC_RELEASE, "agent");
            asm volatile("s_waitcnt vmcnt(0)" ::: "memory");
            const unsigned og = xb_add(&bar[XB_TOP], 1u);
            const unsigned tg = og / nx;
            if (og + 1u == (tg + 1u) * nx) xb_add(&bar[XB_TOPGEN], 1u);
            else XB_SPIN(xb_ld(&bar[XB_TOPGEN]) == tg, bar);
            __builtin_amdgcn_fence(__ATOMIC_ACQUIRE, "agent");
            xb_add(&bar[XB_XGEN(b.x)], 1u);
            asm volatile("s_waitcnt vmcnt(0)" ::: "memory");
        } else {
            XB_SPIN(xb_ld(&bar[XB_XGEN(b.x)]) == gen, bar);
            __builtin_amdgcn_fence(__ATOMIC_ACQUIRE, "agent");
            asm volatile("s_waitcnt vmcnt(0)" ::: "memory");
        }
    }
    __syncthreads();
}


__device__ __forceinline__ void p6_norm_ab(const Args& a, LAS unsigned char* lds) {
    const int tid = threadIdx.x, lane = tid & 63, wave = tid >> 6;
    const int gw = blockIdx.x * NW + wave, NGW = gridDim.x * NW;
    unsigned char* ws = a.ws;
    LAS float* Wl = (LAS float*)lds;
    { const float* wc = (const float*)a.in[12];
      for (int i = tid; i < 16 * 1024; i += NTHR) { const int k = i >> 4, c = i & 15; Wl[c * 1024 + k] = wc[(size_t)k * 4112 + 4096 + c]; } }
    __syncthreads();
    const float* X = (const float*)a.in[0]; const bf16* DL = (const bf16*)(ws + RGN(1)); float* H1 = a.out; const float* g = (const float*)a.in[11]; bf16* XN = (bf16*)(ws + RGN(0));
    float* Gb = (float*)(ws + O_G); float* Bb = (float*)(ws + O_BETA);
    const float* alog = (const float*)a.in[14]; const float* dtb = (const float*)a.in[15];
    f32x4 gv[4];
#pragma unroll
    for (int j = 0; j < 4; ++j) gv[j] = *(const f32x4*)(g + 4 * lane + 256 * j);
    f32x4 nv[4]; v2u nd[4];
    { const int m0 = gw < T_ ? gw : 0; const f32x4* xr = (const f32x4*)(X + (size_t)m0 * D_) + lane; const v2u* dr = (const v2u*)(DL + (size_t)m0 * D_) + lane;
#pragma unroll
      for (int j = 0; j < 4; ++j) { nv[j] = __builtin_nontemporal_load(xr + 64 * j); nd[j] = __builtin_nontemporal_load(dr + 64 * j); } }
    for (int m = gw; m < T_; m += NGW) {
        f32x4 v[4]; float s = 0.f;
        { const int mn = (m + NGW < T_) ? m + NGW : m; const f32x4* xn = (const f32x4*)(X + (size_t)mn * D_) + lane; const v2u* dn = (const v2u*)(DL + (size_t)mn * D_) + lane;
#pragma unroll
          for (int j = 0; j < 4; ++j) { v[j].x = nv[j].x + bflo(nd[j].x); v[j].y = nv[j].y + bfhi(nd[j].x); v[j].z = nv[j].z + bflo(nd[j].y); v[j].w = nv[j].w + bfhi(nd[j].y); nv[j] = __builtin_nontemporal_load(xn + 64 * j); nd[j] = __builtin_nontemporal_load(dn + 64 * j); } }
        { f32x4* hw = (f32x4*)(H1 + (size_t)m * D_) + lane;
#pragma unroll
          for (int j = 0; j < 4; ++j) __builtin_nontemporal_store(v[j], hw + 64 * j); }
#pragma unroll
        for (int j = 0; j < 4; ++j) s += (v[j].x * v[j].x + v[j].y * v[j].y) + (v[j].z * v[j].z + v[j].w * v[j].w);
        const float rs = rsqrtf(wave_sum(s) * (1.f / D_) + EPS);
        v2u* o8 = (v2u*)(XN + (size_t)m * D_) + lane;
#pragma unroll
        for (int j = 0; j < 4; ++j) { v[j] = v[j] * rs * gv[j]; v2u o; o.x = pk2(v[j].x, v[j].y); o.y = pk2(v[j].z, v[j].w); o8[64 * j] = o; }
        asm volatile("" ::: "memory");
        float acc[16];
#pragma unroll
        for (int c = 0; c < 16; ++c) { float s2 = 0.f;
#pragma unroll
            for (int j = 0; j < 4; ++j) { const f32x4 w = *(const LAS f32x4*)(Wl + c * 1024 + 256 * j + 4 * lane); s2 += (v[j].x * w.x + v[j].y * w.y) + (v[j].z * w.z + v[j].w * w.w); }
            acc[c] = s2; }
        float r8[8], r4[4], r2[2], mine;
        { const bool hi = lane & 32;
#pragma unroll
          for (int c = 0; c < 8; ++c) { const float snd = hi ? acc[c] : acc[8 + c]; const float kp = hi ? acc[8 + c] : acc[c]; r8[c] = kp + __shfl_xor(snd, 32); } }
        { const bool hi = lane & 16;
#pragma unroll
          for (int c = 0; c < 4; ++c) { const float snd = hi ? r8[c] : r8[4 + c]; const float kp = hi ? r8[4 + c] : r8[c]; r4[c] = kp + __shfl_xor(snd, 16); } }
        { const bool hi = lane & 8;
#pragma unroll
          for (int c = 0; c < 2; ++c) { const float snd = hi ? r4[c] : r4[2 + c]; const float kp = hi ? r4[2 + c] : r4[c]; r2[c] = kp + __shfl_xor(snd, 8); } }
        { const bool hi = lane & 4; const float snd = hi ? r2[0] : r2[1]; const float kp = hi ? r2[1] : r2[0]; mine = kp + __shfl_xor(snd, 4); }
        mine += __shfl_xor(mine, 2); mine += __shfl_xor(mine, 1);
        const int colc = lane >> 2;
        if ((lane & 3) == 0) {
            if (colc < 8) { const float xx = mine + dtb[colc]; const float sp = fmaxf(xx, 0.f) + __logf(1.f + __expf(-fabsf(xx))); Gb[(size_t)m * 8 + colc] = -__expf(alog[colc]) * sp; }
            else { Bb[(size_t)m * 8 + colc - 8] = __builtin_amdgcn_rcpf(1.f + __expf(-mine)); } }
    }
}

__device__ __forceinline__ void p8a_conv(const Args& a) {
    const int tid = threadIdx.x, lane = tid & 63, wave = tid >> 6;
    const int gw = blockIdx.x * NW + wave, NGW = gridDim.x * NW;
    unsigned char* ws = a.ws; const float* cw = (const float*)a.in[13];
    for (int it = gw; it < 2048 * 6; it += NGW) {
        const int grp = it / 6, sub = it % 6, which = sub >> 1, half = sub & 1;
        const int col = half * 512 + 8 * lane, ch = which * 1024 + col;
        const bf16* src = (const bf16*)(ws + RGN(1 + which)); bf16* dst = (bf16*)(ws + (which == 0 ? RGN(5) : which == 1 ? RGN(6) : RGN(0)));
        const int t0 = grp * 16, ts0 = t0 & (S_ - 1);
        float w[4][8];
#pragma unroll
        for (int j = 0; j < 4; ++j) { const f32x4 w0 = *(const f32x4*)(cw + (size_t)j * 3072 + ch), w1 = *(const f32x4*)(cw + (size_t)j * 3072 + ch + 4);
            w[j][0] = w0.x; w[j][1] = w0.y; w[j][2] = w0.z; w[j][3] = w0.w; w[j][4] = w1.x; w[j][5] = w1.y; w[j][6] = w1.z; w[j][7] = w1.w; }
        v4u xr[19];
#pragma unroll
        for (int i = 0; i < 19; ++i) { const v4u z4 = {0u, 0u, 0u, 0u}; const bool ok = (i >= 3 || ts0 > 0); const int ti = ok ? t0 - 3 + i : t0;
            const v4u ld = __builtin_nontemporal_load((const v4u*)(src + (size_t)ti * 1024 + col)); xr[i] = ok ? ld : z4; }
#pragma unroll
        for (int o = 0; o < 16; ++o) {
            float y[8];
#pragma unroll
            for (int e = 0; e < 8; ++e) y[e] = 0.f;
#pragma unroll
            for (int j = 0; j < 4; ++j) { const v4u v = xr[o + j];
                y[0] += w[j][0] * bflo(v.x); y[1] += w[j][1] * bfhi(v.x); y[2] += w[j][2] * bflo(v.y); y[3] += w[j][3] * bfhi(v.y);
                y[4] += w[j][4] * bflo(v.z); y[5] += w[j][5] * bfhi(v.z); y[6] += w[j][6] * bflo(v.w); y[7] += w[j][7] * bfhi(v.w); }
            float ss = 0.f;
#pragma unroll
            for (int e = 0; e < 8; ++e) { y[e] = silu(y[e]); ss += y[e] * y[e]; }
            float sc = 1.f;
            if (which < 2) { ss = row16_sum(ss);
                sc = rsqrtf(ss + EPS); if (which == 0) sc *= 0.08838834764831845f; }
            v4u ov; ov.x = pk2(y[0] * sc, y[1] * sc); ov.y = pk2(y[2] * sc, y[3] * sc); ov.z = pk2(y[4] * sc, y[5] * sc); ov.w = pk2(y[6] * sc, y[7] * sc);
            *(v4u*)(dst + (size_t)(t0 + o) * 1024 + col) = ov;
        }
    }
}

constexpr int TS = 272, TILE = 17408, L_SET = 2 * TILE, L_M = 2 * L_SET, L_GC = L_M + 4 * TILE;
#define MFMA16(A, B, C) __builtin_amdgcn_mfma_f32_16x16x32_bf16(A, B, C, 0, 0, 0)
__device__ __forceinline__ void p8b_chunk(const Args& a, LAS unsigned char* lds) {
    const int tid0 = threadIdx.x;
    unsigned char* ws = a.ws;
    bf16* QN = (bf16*)(ws + RGN(5)); bf16* KN = (bf16*)(ws + RGN(6)); const bf16* VN = (const bf16*)(ws + RGN(0));
    bf16* KDT = (bf16*)(ws + RGN(1)); bf16* ATT = (bf16*)(ws + RGN(2)); bf16* UT = (bf16*)(ws + RGN(3));
    bf16* QOUT = a.dry ? KDT : QN; bf16* WOUT = a.dry ? UT : KN;
    const float* Gb = (const float*)(ws + O_G); const float* Bb = (const float*)(ws + O_BETA); float* GL = (float*)(ws + O_GL);
    for (int base = blockIdx.x * 4; base < 4096; base += gridDim.x * 4) {
        int tid = tid0; asm volatile("" : "+v"(tid));
        const int lane = tid & 63, wave = __builtin_amdgcn_readfirstlane(tid >> 6), c = lane & 15, g = lane >> 4;
        const int bh = base >> 7, b = bh >> 3, h = bh & 7;
        const size_t tokb = (size_t)b * S_ + (size_t)(base & 127) * 64;
        const int r0 = tid >> 4, ch = tid & 15;
        if (wave < 4) { LAS float* gcs = (LAS float*)(lds + L_GC + wave * 1024); const size_t t0 = tokb + wave * 64;
            float gv = Gb[(t0 + lane) * 8 + h];
#pragma unroll
            for (int o = 1; o < 64; o <<= 1) { const float t = __shfl_up(gv, o); if (lane >= o) gv += t; }
            const float g63 = __shfl(gv, 63);
            gcs[lane] = gv; gcs[64 + lane] = __expf(gv); gcs[128 + lane] = Bb[(t0 + lane) * 8 + h]; gcs[192 + lane] = __expf(g63 - gv);
            if (lane == 63) GL[base + wave] = __expf(gv); }
        v4u pa0, pa1, pb0, pb1;
        { const size_t go = (tokb + r0) * 1024 + h * 128 + ch * 8;
          pa0 = __builtin_nontemporal_load((const v4u*)(QN + go)); pa1 = __builtin_nontemporal_load((const v4u*)(QN + go + 32 * 1024)); pb0 = *(const v4u*)(KN + go); pb1 = *(const v4u*)(KN + go + 32 * 1024);
          *(LAS v4u*)(lds + r0 * TS + ch * 16) = pa0; *(LAS v4u*)(lds + (r0 + 32) * TS + ch * 16) = pa1;
          *(LAS v4u*)(lds + TILE + r0 * TS + ch * 16) = pb0; *(LAS v4u*)(lds + TILE + (r0 + 32) * TS + ch * 16) = pb1; }
        __syncthreads();
#pragma unroll 1
        for (int bc = 0; bc < 4; ++bc) {
            const int cidx = base + bc;
            if (bc < 3) { const size_t go = (tokb + (bc + 1) * 64 + r0) * 1024 + h * 128 + ch * 8;
                pa0 = __builtin_nontemporal_load((const v4u*)(QN + go)); pa1 = __builtin_nontemporal_load((const v4u*)(QN + go + 32 * 1024)); pb0 = *(const v4u*)(KN + go); pb1 = *(const v4u*)(KN + go + 32 * 1024); }
            const int sQ = (bc & 1) * L_SET, sK = sQ + TILE;
            LAS float* gcs = (LAS float*)(lds + L_GC + bc * 1024); LAS float* Ml = (LAS float*)(lds + L_M + bc * TILE);
#pragma unroll 1
            for (int rr = 0; rr < 4; ++rr) {
                const int tsk = wave + 8 * rr, isM = tsk >> 4, tt = tsk & 15, ib = tt >> 2, jb = tt & 3;
                const int i = 16 * ib + c, j0 = 16 * jb + 4 * g;
                const int aoff = ((ib * 2 + (jb >> 1)) * 64 + (2 * (jb & 1) + (g >> 1)) * 16 + c) * 8 + ((4 * g) & 7);
                if (jb <= ib) {
                    f32x4 acc = {0.f, 0.f, 0.f, 0.f};
                    const int xs = isM ? sK : sQ;
#pragma unroll
                    for (int ks = 0; ks < 4; ++ks) {
                        const bf16x8 A = *(const LAS bf16x8*)(lds + sK + (16 * jb + c) * TS + (32 * ks + 8 * g) * 2);
                        const bf16x8 B = *(const LAS bf16x8*)(lds + xs + (16 * ib + c) * TS + (32 * ks + 8 * g) * 2);
                        acc = MFMA16(A, B, acc); }
                    const float gi = gcs[i]; float e[4];
#pragma unroll
                    for (int ii = 0; ii < 4; ++ii) e[ii] = __expf(gi - gcs[j0 + ii]);
                    if (isM) { const float bi = gcs[128 + i]; f32x4 m;
                        m.x = (i > j0 + 0) ? bi * acc[0] * e[0] : 0.f; m.y = (i > j0 + 1) ? bi * acc[1] * e[1] : 0.f; m.z = (i > j0 + 2) ? bi * acc[2] * e[2] : 0.f; m.w = (i > j0 + 3) ? bi * acc[3] * e[3] : 0.f;
                        *(LAS f32x4*)(Ml + i * 68 + j0) = m;
                    } else { const float a0 = (i >= j0 + 0) ? acc[0] * e[0] : 0.f, a1 = (i >= j0 + 1) ? acc[1] * e[1] : 0.f, a2 = (i >= j0 + 2) ? acc[2] * e[2] : 0.f, a3 = (i >= j0 + 3) ? acc[3] * e[3] : 0.f;
                        v2u o; o.x = pk2(a0, a1); o.y = pk2(a2, a3); *(v2u*)(ATT + (size_t)cidx * 4096 + aoff) = o; }
                } else if (!isM) { const v2u o = {0u, 0u}; *(v2u*)(ATT + (size_t)cidx * 4096 + aoff) = o; }
                else { const f32x4 z = {0.f, 0.f, 0.f, 0.f}; *(LAS f32x4*)(Ml + i * 68 + j0) = z; }
            }
            for (int i2 = tid; i2 < 1024; i2 += NTHR) { const int row = i2 >> 4, cc = i2 & 15; const v4u v = *(const LAS v4u*)(lds + sQ + row * TS + cc * 16); const float e = gcs[64 + row]; v4u o;
                o.x = pk2(bflo(v.x) * e, bfhi(v.x) * e); o.y = pk2(bflo(v.y) * e, bfhi(v.y) * e); o.z = pk2(bflo(v.z) * e, bfhi(v.z) * e); o.w = pk2(bflo(v.w) * e, bfhi(v.w) * e);
                const int R = 4 * ((row >> 4) * 4 + (cc >> 2)) + (cc & 3), C = (row & 15) * 8;
                *(v4u*)(QOUT + (tokb + bc * 64 + R) * 1024 + h * 128 + C) = o; }
            if (bc < 3) { const int sn = ((bc + 1) & 1) * L_SET;
                *(LAS v4u*)(lds + sn + r0 * TS + ch * 16) = pa0; *(LAS v4u*)(lds + sn + (r0 + 32) * TS + ch * 16) = pa1;
                *(LAS v4u*)(lds + sn + TILE + r0 * TS + ch * 16) = pb0; *(LAS v4u*)(lds + sn + TILE + (r0 + 32) * TS + ch * 16) = pb1; }
            __syncthreads();
        }
        { const size_t go = (tokb + r0) * 1024 + h * 128 + ch * 8;
          pa0 = *(const v4u*)(KN + go); pa1 = *(const v4u*)(KN + go + 32 * 1024); pb0 = __builtin_nontemporal_load((const v4u*)(VN + go)); pb1 = __builtin_nontemporal_load((const v4u*)(VN + go + 32 * 1024));
          *(LAS v4u*)(lds + r0 * TS + ch * 16) = pa0; *(LAS v4u*)(lds + (r0 + 32) * TS + ch * 16) = pa1;
          *(LAS v4u*)(lds + TILE + r0 * TS + ch * 16) = pb0; *(LAS v4u*)(lds + TILE + (r0 + 32) * TS + ch * 16) = pb1; }
        if (wave < 4) {
            LAS float* Ml = (LAS float*)(lds + L_M + wave * TILE);
            float Tc[64];
            f32x4 mrow[16], mnxt[16];
#pragma unroll
            for (int i = 0; i < 64; ++i) {
#pragma unroll
                for (int j4 = 0; j4 < (i + 4) / 4 && i + 1 < 64; ++j4) mnxt[j4] = *(const LAS f32x4*)(Ml + (i + 1) * 68 + 4 * j4);
                f32x4 acc = {0.f, 0.f, 0.f, 0.f};
#pragma unroll
                for (int j4 = 0; j4 < (i + 3) / 4; ++j4) {
                    const f32x4 m = mrow[j4];
                    if (4 * j4 + 0 < i) acc.x += m.x * Tc[4 * j4 + 0];
                    if (4 * j4 + 1 < i) acc.y += m.y * Tc[4 * j4 + 1];
                    if (4 * j4 + 2 < i) acc.z += m.z * Tc[4 * j4 + 2];
                    if (4 * j4 + 3 < i) acc.w += m.w * Tc[4 * j4 + 3];
                }
                int l2 = lane; asm volatile("" : "+v"(l2));
                Tc[i] = ((l2 == i) ? 1.f : 0.f) - ((acc.x + acc.y) + (acc.z + acc.w));
#pragma unroll
                for (int j4 = 0; j4 < 16; ++j4) mrow[j4] = mnxt[j4];
            }
            asm volatile("" ::: "memory");
#pragma unroll
            for (int i = 0; i < 64; ++i) Ml[i * 68 + lane] = Tc[i];
        }
        __syncthreads();
#pragma unroll 1
        for (int bc = 0; bc < 4; ++bc) {
            const int cidx = base + bc; const size_t tok0 = tokb + bc * 64;
            if (bc < 3) { const size_t go = (tokb + (bc + 1) * 64 + r0) * 1024 + h * 128 + ch * 8;
                pa0 = *(const v4u*)(KN + go); pa1 = *(const v4u*)(KN + go + 32 * 1024); pb0 = __builtin_nontemporal_load((const v4u*)(VN + go)); pb1 = __builtin_nontemporal_load((const v4u*)(VN + go + 32 * 1024)); }
            const int sK = (bc & 1) * L_SET, sV = sK + TILE;
            LAS float* gcs = (LAS float*)(lds + L_GC + bc * 1024); LAS float* Tl = (LAS float*)(lds + L_M + bc * TILE);
            { const int db = wave, q = (lane & 15) >> 2, p = lane & 3;
              bf16x8 Kt[2], Vt[2];
#pragma unroll
              for (int ks = 0; ks < 2; ++ks) { const int off = (32 * ks + 8 * g + q) * TS + (16 * db + 4 * p) * 2;
                  Kt[ks] = cat8(vtr(lds + sK + off), vtr(lds + sK + off + 4 * TS));
                  Vt[ks] = cat8(vtr(lds + sV + off), vtr(lds + sV + off + 4 * TS)); }
#pragma unroll
              for (int ks = 0; ks < 2; ++ks) { const int jb0 = 32 * ks + 8 * g; const v4u kk = __builtin_bit_cast(v4u, Kt[ks]);
                  const f32x4 d0 = *(const LAS f32x4*)(gcs + 192 + jb0), d1 = *(const LAS f32x4*)(gcs + 192 + jb0 + 4); v4u o;
                  o.x = pk2(bflo(kk.x) * d0.x, bfhi(kk.x) * d0.y); o.y = pk2(bflo(kk.y) * d0.z, bfhi(kk.y) * d0.w); o.z = pk2(bflo(kk.z) * d1.x, bfhi(kk.z) * d1.y); o.w = pk2(bflo(kk.w) * d1.z, bfhi(kk.w) * d1.w);
                  *(v4u*)(KDT + (size_t)cidx * 8192 + ((db * 2 + ks) * 64 + lane) * 8) = o; }
              f32x4 su[2][2], sw[2][2];
#pragma unroll
              for (int ks = 0; ks < 2; ++ks)
#pragma unroll
                  for (int hf = 0; hf < 2; ++hf) { su[ks][hf] = *(const LAS f32x4*)(gcs + 128 + 32 * ks + 8 * g + 4 * hf); sw[ks][hf] = su[ks][hf] * *(const LAS f32x4*)(gcs + 64 + 32 * ks + 8 * g + 4 * hf); }
#pragma unroll
              for (int ib = 0; ib < 4; ++ib) {
                  f32x4 aw = {0.f, 0.f, 0.f, 0.f}, au = {0.f, 0.f, 0.f, 0.f};
#pragma unroll
                  for (int ks = 0; ks < 2; ++ks) {
                      const f32x4 t0 = *(const LAS f32x4*)(Tl + (16 * ib + c) * 68 + 32 * ks + 8 * g), t1 = *(const LAS f32x4*)(Tl + (16 * ib + c) * 68 + 32 * ks + 8 * g + 4);
                      const f32x4 w0 = t0 * sw[ks][0], w1 = t1 * sw[ks][1], u0 = t0 * su[ks][0], u1 = t1 * su[ks][1];
                      const bf16x8 Bw = pack8(w0.x, w0.y, w0.z, w0.w, w1.x, w1.y, w1.z, w1.w);
                      const bf16x8 Au = pack8(u0.x, u0.y, u0.z, u0.w, u1.x, u1.y, u1.z, u1.w);
                      aw = MFMA16(Kt[ks], Bw, aw); au = MFMA16(Au, Vt[ks], au); }
                  { v2u o; o.x = pk2(aw[0], aw[1]); o.y = pk2(aw[2], aw[3]); const int R = 4 * (ib * 4 + (db >> 1)) + ((2 * db + (g >> 1)) & 3), C = c * 8 + ((4 * g) & 7);
                    *(v2u*)(WOUT + (tok0 + R) * 1024 + h * 128 + C) = o; }
                  { v2u o; o.x = pk2(au[0], au[1]); o.y = pk2(au[2], au[3]); *(v2u*)(UT + (size_t)cidx * 8192 + ((db * 4 + ib) * 64 + lane) * 4) = o; }
              }
            }
            if (bc < 3) { const int sn = ((bc + 1) & 1) * L_SET;
                *(LAS v4u*)(lds + sn + r0 * TS + ch * 16) = pa0; *(LAS v4u*)(lds + sn + (r0 + 32) * TS + ch * 16) = pa1;
                *(LAS v4u*)(lds + sn + TILE + r0 * TS + ch * 16) = pb0; *(LAS v4u*)(lds + sn + TILE + (r0 + 32) * TS + ch * 16) = pb1; }
            __syncthreads();
        }
    }
}

__device__ __forceinline__ void p9_scan(const Args& a, LAS unsigned char* lds) {
    const int tid = threadIdx.x, lane = tid & 63, wave = __builtin_amdgcn_readfirstlane(tid >> 6), c = lane & 15, g = lane >> 4;
    unsigned char* ws = a.ws;
    const bf16* QD = (const bf16*)(ws + RGN(5)); const bf16* W = (const bf16*)(ws + RGN(6)); const bf16* KDT = (const bf16*)(ws + RGN(1));
    const bf16* ATT = (const bf16*)(ws + RGN(2)); const bf16* UT = (const bf16*)(ws + RGN(3)); bf16* O = (bf16*)(ws + RGN(0)); const float* GL = (const float*)(ws + O_GL);
    const bool first = wave < 4; const int wq = wave & 3;
    constexpr int L_ST = 0, L_VT = 4352;
    for (int it = blockIdx.x; it < 256; it += gridDim.x) {
        const int xcd = it & 7, jj = it >> 3, bh = xcd * 4 + (jj >> 3), slice = jj & 7, b = bh >> 3, h = bh & 7;
        __syncthreads();
        for (int i = tid; i < 4352 / 4; i += NTHR) ((LAS unsigned*)(lds + L_ST))[i] = 0u;
        if (tid < 128) ((LAS float*)(lds + 8192))[tid] = GL[bh * 128 + tid];
        __syncthreads();
        f32x4 Sacc = {0.f, 0.f, 0.f, 0.f};
        const bf16* Ap = (first ? W : QD) + ((size_t)b * S_ + 16 * wq + g) * 1024 + h * 128 + c * 8;
        const bf16* Up = UT + (size_t)(bh * 128) * 8192 + ((slice * 4 + wq) * 64 + lane) * 4;
        const bf16* Xp = ATT + (size_t)(bh * 128) * 4096 + ((wq * 2) * 64 + lane) * 8;
        const size_t ustep = first ? 8192 : 0, xstep = first ? 0 : 4096;
        const bf16* Kp = KDT + (size_t)(bh * 128) * 8192 + ((wave * 2) * 64 + lane) * 8;
        const bool dummy_st = first;
        bf16* Op = dummy_st ? (bf16*)(ws + RGN(2) + 32 * MiB) + (size_t)(blockIdx.x * 8 + wave) * 4096 + lane : O + ((size_t)b * S_ + 16 * wq + 4 * g) * 1024 + h * 128 + slice * 16 + c;
        const size_t ostep = dummy_st ? 0 : 65536;
        const int vtoff = first ? L_VT + c * 144 + (16 * wq + 4 * g) * 2 : L_VT + 2304 + lane * 8;
        bf16x8 Af[4][4], Xf[4][2], Kd[4][2]; v2u uu[4]; float gl[4];
#define SCAN_LOAD(slot, nn) do { \
            _Pragma("unroll") for (int ks = 0; ks < 4; ++ks) Af[slot][ks] = *(const bf16x8*)(Ap + (size_t)(nn) * 65536 + 4096 * ks); \
            _Pragma("unroll") for (int ks = 0; ks < 2; ++ks) Kd[slot][ks] = *(const bf16x8*)(Kp + (size_t)(nn) * 8192 + 512 * ks); \
            uu[slot] = *(const v2u*)(Up + (size_t)(nn) * ustep); Xf[slot][0] = *(const bf16x8*)(Xp + (size_t)(nn) * xstep); Xf[slot][1] = *(const bf16x8*)(Xp + (size_t)(nn) * xstep + 512); \
            gl[slot] = ((const LAS float*)(lds + 8192))[nn]; } while (0)
#pragma unroll
        for (int s4 = 0; s4 < 4; ++s4) { SCAN_LOAD(s4, s4); __builtin_amdgcn_sched_barrier(0); }
#pragma unroll 1
        for (int n0 = 0; n0 < 128; n0 += 4) {
#pragma unroll
            for (int s4 = 0; s4 < 4; ++s4) {
                const int n = n0 + s4;
                f32x4 acc = {0.f, 0.f, 0.f, 0.f}, acc2 = {0.f, 0.f, 0.f, 0.f};
                { const bf16x8 S0 = *(const LAS bf16x8*)(lds + L_ST + c * 272 + (8 * g) * 2), S1 = *(const LAS bf16x8*)(lds + L_ST + c * 272 + (32 + 8 * g) * 2);
                  const bf16x8 S2 = *(const LAS bf16x8*)(lds + L_ST + c * 272 + (64 + 8 * g) * 2), S3 = *(const LAS bf16x8*)(lds + L_ST + c * 272 + (96 + 8 * g) * 2);
                  acc = MFMA16(Af[s4][0], S0, acc); acc2 = MFMA16(Af[s4][1], S1, acc2); acc = MFMA16(Af[s4][2], S2, acc); acc2 = MFMA16(Af[s4][3], S3, acc2); acc = acc + acc2; }
                { v2u o; o.x = pk2(bflo(uu[s4].x) - acc[0], bfhi(uu[s4].x) - acc[1]); o.y = pk2(bflo(uu[s4].y) - acc[2], bfhi(uu[s4].y) - acc[3]);
                    *(LAS v2u*)(lds + vtoff) = o; }
                __syncthreads();
                bf16x8 Vb[2];
#pragma unroll
                for (int ks = 0; ks < 2; ++ks) Vb[ks] = *(const LAS bf16x8*)(lds + L_VT + c * 144 + (32 * ks + 8 * g) * 2);
                { acc = MFMA16(Xf[s4][0], Vb[0], acc); acc = MFMA16(Xf[s4][1], Vb[1], acc);
                    bf16* op = Op + (size_t)n * ostep; const unsigned p01 = pk2(acc[0], acc[1]), p23 = pk2(acc[2], acc[3]);
                    op[0] = (bf16)(p01 & 0xffffu); op[1024] = (bf16)(p01 >> 16); op[2048] = (bf16)(p23 & 0xffffu); op[3072] = (bf16)(p23 >> 16); }
                Sacc = Sacc * gl[s4];
                Sacc = MFMA16(Kd[s4][0], Vb[0], Sacc); Sacc = MFMA16(Kd[s4][1], Vb[1], Sacc);
                { v2u o; o.x = pk2(Sacc[0], Sacc[1]); o.y = pk2(Sacc[2], Sacc[3]); *(LAS v2u*)(lds + L_ST + c * 272 + (16 * wave + 4 * g) * 2) = o; }
                const int nl = (n + 4 < 128) ? n + 4 : n;
                SCAN_LOAD(s4, nl);
                __syncthreads();
            }
        }
#undef SCAN_LOAD
    }
}

__device__ __forceinline__ void p10_gate(const Args& a) {
    const int tid = threadIdx.x, lane = tid & 63, wave = tid >> 6;
    const int gw = blockIdx.x * NW + wave, NGW = gridDim.x * NW;
    unsigned char* ws = a.ws;
    const bf16* O = (const bf16*)(ws + RGN(0)); const bf16* Z = (const bf16*)(ws + RGN(4)); bf16* Y1 = (bf16*)(ws + RGN(1));
    const float* on = (const float*)a.in[16];
    float gn[16];
#pragma unroll
    for (int e = 0; e < 16; ++e) gn[e] = on[(16 * lane + e) & 127];
    for (int m = gw; m < T_; m += NGW) {
        const size_t off = (size_t)m * 1024 + 16 * lane;
        const v4u o0 = __builtin_nontemporal_load((const v4u*)(O + off)), o1 = __builtin_nontemporal_load((const v4u*)(O + off + 8)), z0 = __builtin_nontemporal_load((const v4u*)(Z + off)), z1 = __builtin_nontemporal_load((const v4u*)(Z + off + 8));
        float ov[16] = {bflo(o0.x), bfhi(o0.x), bflo(o0.y), bfhi(o0.y), bflo(o0.z), bfhi(o0.z), bflo(o0.w), bfhi(o0.w), bflo(o1.x), bfhi(o1.x), bflo(o1.y), bfhi(o1.y), bflo(o1.z), bfhi(o1.z), bflo(o1.w), bfhi(o1.w)};
        const float zv[16] = {bflo(z0.x), bfhi(z0.x), bflo(z0.y), bfhi(z0.y), bflo(z0.z), bfhi(z0.z), bflo(z0.w), bfhi(z0.w), bflo(z1.x), bfhi(z1.x), bflo(z1.y), bfhi(z1.y), bflo(z1.z), bfhi(z1.z), bflo(z1.w), bfhi(z1.w)};
        float ss = 0.f;
#pragma unroll
        for (int e = 0; e < 16; ++e) ss += ov[e] * ov[e];
        ss += __shfl_xor(ss, 1); ss += __shfl_xor(ss, 2); ss += __shfl_xor(ss, 4);
        const float rs = rsqrtf(ss * (1.f / 128.f) + EPS);
#pragma unroll
        for (int e = 0; e < 16; ++e) ov[e] = ov[e] * rs * gn[e] * silu(zv[e]);
        v4u r0, r1; r0.x = pk2(ov[0], ov[1]); r0.y = pk2(ov[2], ov[3]); r0.z = pk2(ov[4], ov[5]); r0.w = pk2(ov[6], ov[7]);
        r1.x = pk2(ov[8], ov[9]); r1.y = pk2(ov[10], ov[11]); r1.z = pk2(ov[12], ov[13]); r1.w = pk2(ov[14], ov[15]);
        *(v4u*)(Y1 + off) = r0; *(v4u*)(Y1 + off + 8) = r1;
    }
}

__device__ __forceinline__ void p12_final(const Args& a) {
    const int tid = threadIdx.x, lane = tid & 63, wave = tid >> 6;
    const int gw = blockIdx.x * NW + wave, NGW = gridDim.x * NW;
    const float* g = (const float*)a.in[18];
    f32x4 gv[4];
#pragma unroll
    for (int j = 0; j < 4; ++j) gv[j] = *(const f32x4*)(g + 4 * lane + 256 * j);
    const bf16* DL = (const bf16*)(a.ws + RGN(2));
    f32x4 nv[4]; v2u nd[4];
    { const int m0 = gw < T_ ? gw : 0; const f32x4* xr0 = (const f32x4*)(a.out + (size_t)m0 * D_) + lane; const v2u* dr = (const v2u*)(DL + (size_t)m0 * D_) + lane;
#pragma unroll
      for (int j = 0; j < 4; ++j) { nv[j] = __builtin_nontemporal_load(xr0 + 64 * j); nd[j] = __builtin_nontemporal_load(dr + 64 * j); } }
    for (int m = gw; m < T_; m += NGW) {
        f32x4* xw = (f32x4*)(a.out + (size_t)m * D_) + lane; f32x4 v[4]; float s = 0.f;
        { const int mn = (m + NGW < T_) ? m + NGW : m; const f32x4* xn = (const f32x4*)(a.out + (size_t)mn * D_) + lane; const v2u* dn = (const v2u*)(DL + (size_t)mn * D_) + lane;
#pragma unroll
          for (int j = 0; j < 4; ++j) { v[j].x = nv[j].x + bflo(nd[j].x); v[j].y = nv[j].y + bfhi(nd[j].x); v[j].z = nv[j].z + bflo(nd[j].y); v[j].w = nv[j].w + bfhi(nd[j].y); nv[j] = __builtin_nontemporal_load(xn + 64 * j); nd[j] = __builtin_nontemporal_load(dn + 64 * j); } }
#pragma unroll
        for (int j = 0; j < 4; ++j) s += (v[j].x * v[j].x + v[j].y * v[j].y) + (v[j].z * v[j].z + v[j].w * v[j].w);
        const float rs = rsqrtf(wave_sum(s) * (1.f / D_) + EPS);
#pragma unroll
        for (int j = 0; j < 4; ++j) __builtin_nontemporal_store(v[j] * rs * gv[j], xw + 64 * j);
    }
}

constexpr int NPH = 13;
__global__ void __launch_bounds__(NTHR, 2) fwd(Args a) {
    extern __shared__ __attribute__((aligned(16))) unsigned char smem[];
    LAS unsigned char* lds = (LAS unsigned char*)smem;
    cg::grid_group grid = cg::this_grid();
    unsigned char* ws = a.ws;
    const int G = gridDim.x, bx = blockIdx.x;
#define IN(k) (a.ph_lo <= (k) && (k) < a.ph_hi)
    volatile LAS unsigned* xst = (volatile LAS unsigned*)(lds + LDS_BYTES - 16);
    if (threadIdx.x < 4) xst[threadIdx.x] = 0u;
    __syncthreads();
    XcdBarrier xbar; xbar.bar = (unsigned*)(ws + O_BAR); xbar.x = 0; xbar.st = xst;
#define SEAM(k) do { if (IN(k) && IN((k) + 1)) xcd_barrier(xbar); } while (0)
    if (IN(0) && IN(1)) { if (blockIdx.x == 0) for (int i = threadIdx.x; i < XCD_BAR_WORDS; i += NTHR) ((unsigned*)(ws + O_BAR))[i] = 0u;
                          grid.sync(); xbar = xcd_barrier_post((unsigned*)(ws + O_BAR), xst); }
    if (IN(0)) p0_prologue(a, lds);
    SEAM(0);
    if (IN(1)) { pg8::Gemm g{(const bf16*)(ws + RGN(0)), (const bf16*)(ws + O_WIN0), T_, 2048, 1024}; pg8::StaticOrder S; S.init(T_, 2048, G, bx);
        pg8::EpiB E{(bf16*)(ws + RGN(1)), P0LD, 0, 0}; pg8::gemm_phase<pg8::EpiB, pg8::StaticOrder, true, true>(lds, g, S, E); }
    SEAM(1);
    if (IN(2)) p2_prep(a);
    SEAM(2);
    if (IN(3)) {
        { pg8::Gemm g{(const bf16*)(ws + RGN(5)), (const bf16*)(ws + O_WQKV), T_, 1792, 384}; pg8::StaticOrder S; S.init(T_, 1792, G, bx);
          pg8::EpiB E{(bf16*)(ws + O_QKV), 1792, 0, 0}; pg8::gemm_phase<pg8::EpiB, pg8::StaticOrder, true, true>(lds, g, S, E); }
        { pg8::Gemm g{(const bf16*)(ws + RGN(5) + 26 * MiB), (const bf16*)(ws + O_WPOOL), T_, 512, 512}; pg8::StaticOrder S; S.init(T_, 512, G, bx);
          pg8::EpiGate E{(bf16*)(ws + RGN(0)) + 512, 1024, (const bf16*)(ws + RGN(1)) + 1440, P0LD, (const float*)a.in[9]};
          pg8::gemm_phase<pg8::EpiGate, pg8::StaticOrder, true, true>(lds, g, S, E); }
    }
    SEAM(3);
    if (IN(4)) p4_attn(a, lds);
    SEAM(4);
    if (IN(5)) { pg8::Gemm g{(const bf16*)(ws + RGN(0)), (const bf16*)(ws + O_WOUTAB), T_, 1024, 1024}; pg8::StaticOrder S; S.init(T_, 1024, G, bx);
        pg8::EpiB E{(bf16*)(ws + RGN(1)), 1024, 0, 0}; pg8::gemm_phase<pg8::EpiB, pg8::StaticOrder, true, true>(lds, g, S, E); }
    SEAM(5);
    if (IN(6)) p6_norm_ab(a, lds);
    SEAM(6);
    if (IN(7)) { pg8::Gemm g{(const bf16*)(ws + RGN(0)), (const bf16*)(ws + O_WINC), T_, 4096, 1024}; pg8::StaticOrder S; S.init(T_, 4096, G, bx);
        pg8::EpiB E{(bf16*)(ws + RGN(1)), 1024, 1024, REG / 2}; pg8::gemm_phase<pg8::EpiB, pg8::StaticOrder, true, true>(lds, g, S, E); }
    SEAM(7);
    if (IN(8)) p8a_conv(a);
    SEAM(8);
    if (IN(9)) p8b_chunk(a, lds);
    SEAM(9);
    if (IN(10)) p9_scan(a, lds);
    SEAM(10);
    if (IN(11)) p10_gate(a);
    SEAM(11);
    if (IN(12)) { pg8::Gemm g{(const bf16*)(ws + RGN(1)), (const bf16*)(ws + O_WOUTC), T_, 1024, 1024}; pg8::StaticOrder S; S.init(T_, 1024, G, bx);
        pg8::EpiB E{(bf16*)(ws + RGN(2)), 1024, 0, 0}; pg8::gemm_phase<pg8::EpiB, pg8::StaticOrder, true, true>(lds, g, S, E); }
    SEAM(12);
    if (IN(13)) p12_final(a);
}

#ifndef MK_MULTI
#define MK_MULTI 0
#endif
extern "C" void kernel_launch(void* const* d_in, const int* in_sizes, int n_in, void* d_out, int out_size, void* d_ws, size_t ws_size, hipStream_t stream) {
    static int grid = 0;
    if (grid == 0) {
        if (n_in != 19 || out_size != T_ * D_ || ws_size < WS_NEED) { fprintf(stderr, "kernel_launch: unexpected shapes (n_in %d out %d ws %zu need %zu)\n", n_in, out_size, ws_size, (size_t)WS_NEED); grid = -1; return; }
        int dev = 0, cus = 0, per_cu = 0;
        hipGetDevice(&dev); hipDeviceGetAttribute(&cus, hipDeviceAttributeMultiprocessorCount, dev);
        if (hipFuncSetAttribute((const void*)fwd, hipFuncAttributeMaxDynamicSharedMemorySize, LDS_BYTES) != hipSuccess) { fprintf(stderr, "kernel_launch: hipFuncSetAttribute failed\n"); grid = -1; return; }
        hipOccupancyMaxActiveBlocksPerMultiprocessor(&per_cu, (const void*)fwd, NTHR, LDS_BYTES);
        (void)hipGetLastError();
        if (per_cu < 1) per_cu = 1;
        grid = cus * 1;
        if (grid > 256) grid = 256;
    }
    if (grid < 0) return;
    Args a{};
    for (int i = 0; i < 19; ++i) a.in[i] = d_in[i];
    a.out = (float*)d_out; a.ws = (unsigned char*)d_ws;
    for (int i = 0; i < 16; ++i) a.inv_freq[i] = 1.0f / powf(10000.0f, (float)i / 16.0f);
#if MK_MULTI
#ifndef PROBE_PH
#define PROBE_PH -1
#endif
#ifndef PROBE_REPS
#define PROBE_REPS 0
#endif
    for (int p = 0; p <= NPH; ++p) { const int reps = 1 + (p == PROBE_PH ? PROBE_REPS : 0);
        for (int r = 0; r < reps; ++r) { a.ph_lo = p; a.ph_hi = p + 1; a.dry = (p == 9 && r + 1 < reps) ? 1 : 0;
#ifdef PROBE_DRYMODE
            if (p == 10 && r + 1 < reps) a.dry = PROBE_DRYMODE;
#endif
            hipLaunchKernelGGL(fwd, dim3(grid), dim3(NTHR), LDS_BYTES, stream, a); } }
#else
    a.ph_lo = 0; a.ph_hi = NPH + 1;
    void* args[] = {&a};
    hipError_t e = hipLaunchCooperativeKernel((const void*)fwd, dim3(grid), dim3(NTHR), args, LDS_BYTES, stream);
    if (e != hipSuccess) fprintf(stderr, "cooperative launch failed: %s (grid %d)\n", hipGetErrorString(e), grid);
#endif
}
```

```cpp
#include <hip/hip_runtime.h>
#include <hip/hip_cooperative_groups.h>
#include <cstdio>
#include <cstdint>
#include <cmath>
namespace cg = cooperative_groups;
namespace pg8 {
#define PG8_LAS __attribute__((address_space(3)))
typedef unsigned short bf16_t;
typedef short bf16x8 __attribute__((ext_vector_type(8)));
typedef float f32x4 __attribute__((ext_vector_type(4)));
typedef unsigned u32x4 __attribute__((ext_vector_type(4)));
constexpr int BM = 256, BK = 64, HALF = 128, HTB = HALF * BK * 2  , STAGE_BYTES = 8 * HTB, NXCD = 8, WGM = 8;

__host__ __device__ __forceinline__ int lds_byte(int r, int c) { const int st = (r >> 4) * 2 + (c >> 5), rr = r & 15, cc = c & 31, ob = rr * 64 + cc * 2; return st * 1024 + (ob ^ (((ob >> 9) & 1) << 5)); }
__host__ __device__ __forceinline__ void stage_rc(int b, int& R, int& C) { const int st = b / 1024, sb = b % 1024, swz = sb ^ (((sb >> 9) & 1) << 5); R = (st >> 1) * 16 + swz / 64; C = (st & 1) * 32 + (swz % 64) / 2; }
__host__ __device__ __forceinline__ int perm32(int rho) { const int n = rho >> 4, i = rho & 15; return 8 * (i >> 2) + 4 * n + (i & 3); }

struct Unit { int pm, pn; };
struct Gemm { const bf16_t* A; const bf16_t* Bt; int M, N, K; };

struct StaticOrder {
    int nM, nN, nwg, G, c;
    __host__ __device__ void init(int M, int N, int G_, int c_) { nM = M / BM; nN = N / BM; nwg = nM * nN; G = G_; c = c_; }
    __host__ __device__ bool next(int i, Unit& u) const {
        const long L = (long)i * G + c; if (L >= nwg) return false;
        int wgid = (int)L; { const int q = nwg / NXCD, r = nwg % NXCD, xcd = wgid % NXCD, off = wgid / NXCD; wgid = (xcd < r ? xcd * (q + 1) : r * (q + 1) + (xcd - r) * q) + off; }
        const int nig = WGM * nN, gid = wgid / nig, fm = gid * WGM, gsz = (nM - fm) < WGM ? (nM - fm) : WGM;
        u.pm = fm + ((wgid % nig) % gsz); u.pn = (wgid % nig) / gsz; return true;
    }
    __device__ __forceinline__ void a_ready(const Unit&) const {}
    __device__ __forceinline__ void done(const Unit&) const {}
};

__device__ __forceinline__ unsigned cvt_pk_bf16(float lo, float hi) { unsigned r; asm volatile("v_cvt_pk_bf16_f32 %0, %1, %2" : "=v"(r) : "v"(lo), "v"(hi)); return r; }

__device__ __forceinline__ unsigned lane_xpose(unsigned v, int src4) { return (unsigned)__builtin_amdgcn_ds_bpermute(src4, (int)v); }
__device__ __forceinline__ float lane_xposef(float v, int src4) { return __builtin_bit_cast(float, __builtin_amdgcn_ds_bpermute(src4, __builtin_bit_cast(int, v))); }
struct EpiB {
    static constexpr bool PERM = true, AFTER_DRAIN = false;
    bf16_t* O; int ldc; int split_cols; size_t split_stride;
    __device__ __forceinline__ void operator()(const f32x4 (&acc)[2][2][4][2], const Unit& u, int wr, int wc, int fr, int fq) const {
        const int L = fq * 16 + fr, Lr = L >> 2, Lq = L & 3, src4 = (16 * Lq + Lr) * 4;
        const int row0 = u.pm * BM + wr * 64 + Lr; int colt = u.pn * BM; bf16_t* base = O;
        if (split_cols) { const int t = colt / split_cols; base += (size_t)t * split_stride; colt -= t * split_cols; }
        const int col0 = colt + wc * 32 + 8 * Lq;
#pragma unroll
        for (int ai = 0; ai < 2; ++ai)
#pragma unroll
            for (int m = 0; m < 4; ++m) { bf16_t* rowp = base + (size_t)(row0 + ai * HALF + m * 16) * ldc + col0;
#pragma unroll
                for (int bj = 0; bj < 2; ++bj) { const f32x4 v0 = acc[ai][bj][m][0], v1 = acc[ai][bj][m][1];
                    u32x4 w; w.x = lane_xpose(cvt_pk_bf16(v0[0], v0[1]), src4); w.y = lane_xpose(cvt_pk_bf16(v0[2], v0[3]), src4); w.z = lane_xpose(cvt_pk_bf16(v1[0], v1[1]), src4); w.w = lane_xpose(cvt_pk_bf16(v1[2], v1[3]), src4);
                    *(u32x4*)(rowp + bj * HALF) = w; } }
    }
};
struct EpiRes {
    static constexpr bool PERM = true, AFTER_DRAIN = false;
    const float* R; float* O; int ldc;
    __device__ __forceinline__ void operator()(const f32x4 (&acc)[2][2][4][2], const Unit& u, int wr, int wc, int fr, int fq) const {
        const int L = fq * 16 + fr, Lr = L >> 2, Lq = L & 3, src4 = (16 * Lq + Lr) * 4;
        const int row0 = u.pm * BM + wr * 64 + Lr; const int col0 = u.pn * BM + wc * 32 + 8 * Lq;
#pragma unroll
        for (int ai = 0; ai < 2; ++ai)
#pragma unroll
            for (int m = 0; m < 4; ++m) { const size_t ro = (size_t)(row0 + ai * HALF + m * 16) * ldc + col0;
#pragma unroll
                for (int bj = 0; bj < 2; ++bj) { const size_t o = ro + bj * HALF;
                    const f32x4 r0 = *(const f32x4*)(R + o), r1 = *(const f32x4*)(R + o + 4);
                    const f32x4 s0 = acc[ai][bj][m][0], s1 = acc[ai][bj][m][1];
                    f32x4 a0, a1;
                    a0.x = lane_xposef(s0.x, src4); a0.y = lane_xposef(s0.y, src4); a0.z = lane_xposef(s0.z, src4); a0.w = lane_xposef(s0.w, src4);
                    a1.x = lane_xposef(s1.x, src4); a1.y = lane_xposef(s1.y, src4); a1.z = lane_xposef(s1.z, src4); a1.w = lane_xposef(s1.w, src4);
                    *(f32x4*)(O + o) = r0 + a0; *(f32x4*)(O + o + 4) = r1 + a1; } }
    }
};
struct EpiGate {
    static constexpr bool PERM = true, AFTER_DRAIN = false;
    bf16_t* O; int ldc; const bf16_t* Z; int ldz; const float* PS;
    __device__ __forceinline__ void operator()(const f32x4 (&acc)[2][2][4][2], const Unit& u, int wr, int wc, int fr, int fq) const {
        const int L = fq * 16 + fr, Lr = L >> 2, Lq = L & 3, src4 = (16 * Lq + Lr) * 4;
        const int row0 = u.pm * BM + wr * 64 + Lr; const int col0 = u.pn * BM + wc * 32 + 8 * Lq;
#pragma unroll
        for (int ai = 0; ai < 2; ++ai)
#pragma unroll
            for (int m = 0; m < 4; ++m) { const size_t row = (size_t)(row0 + ai * HALF + m * 16);
#pragma unroll
                for (int bj = 0; bj < 2; ++bj) { const int col = col0 + bj * HALF;
                    const f32x4 s0 = acc[ai][bj][m][0], s1 = acc[ai][bj][m][1];
                    const float a0 = lane_xposef(s0.x, src4), a1 = lane_xposef(s0.y, src4), a2 = lane_xposef(s0.z, src4), a3 = lane_xposef(s0.w, src4);
                    const float a4 = lane_xposef(s1.x, src4), a5 = lane_xposef(s1.y, src4), a6 = lane_xposef(s1.z, src4), a7 = lane_xposef(s1.w, src4);
                    const u32x4 z = __builtin_nontemporal_load((const u32x4*)(Z + row * ldz + col)); const f32x4 p0 = *(const f32x4*)(PS + col), p1 = *(const f32x4*)(PS + col + 4);
                    const float z0 = __builtin_bit_cast(float, z.x << 16), z1 = __builtin_bit_cast(float, z.x & 0xffff0000u), z2 = __builtin_bit_cast(float, z.y << 16), z3 = __builtin_bit_cast(float, z.y & 0xffff0000u);
                    const float z4 = __builtin_bit_cast(float, z.z << 16), z5 = __builtin_bit_cast(float, z.z & 0xffff0000u), z6 = __builtin_bit_cast(float, z.w << 16), z7 = __builtin_bit_cast(float, z.w & 0xffff0000u);
#define PG8_SILU(x) ((x) * __builtin_amdgcn_rcpf(1.f + __expf(-(x))))
                    u32x4 w; w.x = cvt_pk_bf16(a0 * p0.x * PG8_SILU(z0), a1 * p0.y * PG8_SILU(z1)); w.y = cvt_pk_bf16(a2 * p0.z * PG8_SILU(z2), a3 * p0.w * PG8_SILU(z3));
                    w.z = cvt_pk_bf16(a4 * p1.x * PG8_SILU(z4), a5 * p1.y * PG8_SILU(z5)); w.w = cvt_pk_bf16(a6 * p1.z * PG8_SILU(z6), a7 * p1.w * PG8_SILU(z7));
#undef PG8_SILU
                    *(u32x4*)(O + row * ldc + col) = w; } }
    }
};
template <class Epi, class Sched, bool ALIGN_EPI = false, bool SP2 = false>
__device__ __forceinline__ void gemm_phase(PG8_LAS unsigned char* lds, const Gemm g, const Sched& S, const Epi& E) {
    const int tid = threadIdx.x, wid = __builtin_amdgcn_readfirstlane(tid >> 6), lane = tid & 63, wr = wid >> 2, wc = wid & 3, fr = lane & 15, fq = lane >> 4;
    const int K = g.K, nt = K / BK;
    unsigned voffA[2], voffB[2];
#pragma unroll
    for (int i = 0; i < 2; ++i) { int R, C; stage_rc(tid * 16 + i * 8192, R, C); const int Rb = Epi::PERM ? ((R & ~31) + perm32(R & 31)) : R;
        voffA[i] = (unsigned)(R * K + C) * 2u; voffB[i] = (unsigned)(Rb * K + C) * 2u; }
    const size_t kstep = (size_t)(BK * 2);
    const size_t hstep = (size_t)HALF * K * 2;
    const size_t tstep = 2 * hstep;
    const unsigned ldsw = (unsigned)wid * 1024u;
    const int aoff = lds_byte(wr * 64 + fr, fq * 8), boff = lds_byte(wc * 32 + fr, fq * 8);
#define PG8_SA(b, h) (((b) * 2 + (h)) * HTB)
#define PG8_SB(b, h) ((4 + (b) * 2 + (h)) * HTB)
#define PG8_STAGE(bufoff, gbase, voff) do { _Pragma("unroll") for (int _i = 0; _i < 2; ++_i) \
        __builtin_amdgcn_global_load_lds((const unsigned*)((const char*)(gbase) + (voff)[_i]), (PG8_LAS unsigned*)(lds + (bufoff) + ldsw + _i * 8192), 16, 0, 0); } while (0)
#define PG8_LDA(dst, b, h) do { _Pragma("unroll") for (int m = 0; m < 4; ++m) _Pragma("unroll") for (int k = 0; k < 2; ++k) dst[m][k] = *(const PG8_LAS bf16x8*)(lds + PG8_SA(b, h) + aoff + m * 2048 + k * 1024); } while (0)
#define PG8_LDB(dst, b, h) do { _Pragma("unroll") for (int n = 0; n < 2; ++n) _Pragma("unroll") for (int k = 0; k < 2; ++k) dst[n][k] = *(const PG8_LAS bf16x8*)(lds + PG8_SB(b, h) + boff + n * 2048 + k * 1024); } while (0)
#define PG8_MMA(ai, bj, At, Bt) do { __builtin_amdgcn_s_setprio(1); _Pragma("unroll") for (int m = 0; m < 4; ++m) _Pragma("unroll") for (int n = 0; n < 2; ++n) _Pragma("unroll") for (int k = 0; k < 2; ++k) \
        acc[ai][bj][m][n] = __builtin_amdgcn_mfma_f32_16x16x32_bf16(Bt[n][k], At[m][k], acc[ai][bj][m][n], 0, 0, 0); __builtin_amdgcn_s_setprio(0); } while (0)
#define PG8_WAIT_V(n) asm volatile("s_waitcnt vmcnt(" #n ")" ::: "memory")
#define PG8_WAIT_L(n) asm volatile("s_waitcnt lgkmcnt(" #n ")" ::: "memory")
#define PG8_BAR __builtin_amdgcn_s_barrier()
#define PG8_SCHED __builtin_amdgcn_sched_barrier(0)
    Unit cur, nxt; int ui = 0;
    if (!S.next(0, cur)) return;
    f32x4 acc[2][2][4][2];
#pragma unroll
    for (int a = 0; a < 2; ++a)
#pragma unroll
        for (int b = 0; b < 2; ++b)
#pragma unroll
            for (int m = 0; m < 4; ++m)
#pragma unroll
                for (int n = 0; n < 2; ++n) acc[a][b][m][n] = (f32x4){0.f, 0.f, 0.f, 0.f};
    bf16x8 At[4][2], B0[2][2], B1[2][2];
    const char* cA = (const char*)g.A + (size_t)cur.pm * tstep; const char* cB = (const char*)g.Bt + (size_t)cur.pn * tstep;
    S.a_ready(cur);
    if constexpr (SP2) {
        PG8_STAGE(PG8_SB(0, 0), cB, voffB); PG8_STAGE(PG8_SB(0, 1), cB + hstep, voffB); PG8_STAGE(PG8_SA(0, 0), cA, voffA); PG8_STAGE(PG8_SA(0, 1), cA + hstep, voffA);
        if (wr == 1) PG8_BAR;
        PG8_WAIT_V(2); PG8_BAR;
        PG8_STAGE(PG8_SB(1, 0), cB + kstep, voffB); PG8_STAGE(PG8_SA(1, 0), cA + kstep, voffA); PG8_STAGE(PG8_SB(1, 1), cB + hstep + kstep, voffB);
        PG8_WAIT_V(6); PG8_BAR;
    } else {
        PG8_STAGE(PG8_SB(0, 0), cB, voffB); PG8_STAGE(PG8_SA(0, 0), cA, voffA); PG8_STAGE(PG8_SB(0, 1), cB + hstep, voffB); PG8_STAGE(PG8_SA(0, 1), cA + hstep, voffA);
        if (wr == 1) PG8_BAR;
        PG8_WAIT_V(4); PG8_BAR;
        PG8_STAGE(PG8_SB(1, 0), cB + kstep, voffB); PG8_STAGE(PG8_SA(1, 0), cA + kstep, voffA); PG8_STAGE(PG8_SB(1, 1), cB + hstep + kstep, voffB);
        PG8_WAIT_V(6); PG8_BAR;
    }
    for (;;) {
        const bool has_next = S.next(ui + 1, nxt);
        const char* nA = has_next ? (const char*)g.A + (size_t)nxt.pm * tstep : cA; const char* nB = has_next ? (const char*)g.Bt + (size_t)nxt.pn * tstep : cB;
        for (int t = 0; t < nt; t += 2) {
            const bool last = (t == nt - 2);
            const char* a1 = cA + (size_t)(t + 1) * kstep;
            const char* a2 = last ? nA : cA + (size_t)(t + 2) * kstep; const char* b2 = last ? nB : cB + (size_t)(t + 2) * kstep;
            const char* a3 = a2 + kstep; const char* b3 = b2 + kstep;
            if (last && has_next) S.a_ready(nxt);
            if constexpr (SP2) {
            PG8_LDB(B0, 0, 0); PG8_LDB(B1, 0, 1); PG8_SCHED; PG8_LDA(At, 0, 0); PG8_STAGE(PG8_SA(1, 1), a1 + hstep, voffA);
            PG8_WAIT_V(8); PG8_WAIT_L(0); PG8_BAR; PG8_MMA(0, 0, At, B0); PG8_MMA(0, 1, At, B1); PG8_BAR; PG8_SCHED;
            PG8_LDA(At, 0, 1); PG8_STAGE(PG8_SB(0, 0), b2, voffB); PG8_STAGE(PG8_SB(0, 1), b2 + hstep, voffB); PG8_STAGE(PG8_SA(0, 0), a2, voffA);
            PG8_WAIT_V(8); PG8_WAIT_L(0); PG8_BAR; PG8_MMA(1, 0, At, B0); PG8_MMA(1, 1, At, B1); PG8_BAR; PG8_SCHED;
            PG8_LDB(B0, 1, 0); PG8_LDB(B1, 1, 1); PG8_SCHED; PG8_LDA(At, 1, 0); PG8_STAGE(PG8_SA(0, 1), a2 + hstep, voffA);
            PG8_WAIT_V(8); PG8_WAIT_L(0); PG8_BAR; PG8_MMA(0, 0, At, B0); PG8_MMA(0, 1, At, B1); PG8_BAR; PG8_SCHED;
            PG8_LDA(At, 1, 1); PG8_STAGE(PG8_SB(1, 0), b3, voffB); PG8_STAGE(PG8_SB(1, 1), b3 + hstep, voffB); PG8_STAGE(PG8_SA(1, 0), a3, voffA);
            PG8_WAIT_V(8); PG8_WAIT_L(0); PG8_BAR; PG8_MMA(1, 0, At, B0); PG8_MMA(1, 1, At, B1); PG8_BAR; PG8_SCHED;
            } else {
            PG8_LDB(B0, 0, 0); PG8_SCHED; PG8_LDA(At, 0, 0); PG8_STAGE(PG8_SA(1, 1), a1 + hstep, voffA);
            PG8_WAIT_L(8); PG8_BAR; PG8_WAIT_L(0); PG8_MMA(0, 0, At, B0); PG8_BAR; PG8_SCHED;
            PG8_LDB(B1, 0, 1); PG8_STAGE(PG8_SB(0, 0), b2, voffB);
            PG8_BAR; PG8_WAIT_L(0); PG8_MMA(0, 1, At, B1); PG8_BAR;
            PG8_LDA(At, 0, 1); PG8_STAGE(PG8_SA(0, 0), a2, voffA);
            PG8_BAR; PG8_WAIT_L(0); PG8_MMA(1, 0, At, B0); PG8_BAR; PG8_SCHED;
            PG8_STAGE(PG8_SB(0, 1), b2 + hstep, voffB);
            PG8_WAIT_V(6); PG8_BAR; PG8_MMA(1, 1, At, B1); PG8_BAR;
            PG8_LDB(B0, 1, 0); PG8_SCHED; PG8_LDA(At, 1, 0); PG8_STAGE(PG8_SA(0, 1), a2 + hstep, voffA);
            PG8_WAIT_L(8); PG8_BAR; PG8_WAIT_L(0); PG8_MMA(0, 0, At, B0); PG8_BAR; PG8_SCHED;
            PG8_LDB(B1, 1, 1); PG8_STAGE(PG8_SB(1, 0), b3, voffB);
            PG8_BAR; PG8_WAIT_L(0); PG8_MMA(0, 1, At, B1); PG8_BAR;
            PG8_LDA(At, 1, 1); PG8_STAGE(PG8_SA(1, 0), a3, voffA);
            PG8_BAR; PG8_WAIT_L(0); PG8_MMA(1, 0, At, B0); PG8_BAR; PG8_SCHED;
            PG8_STAGE(PG8_SB(1, 1), b3 + hstep, voffB);
            PG8_WAIT_V(6); PG8_BAR; PG8_MMA(1, 1, At, B1); PG8_BAR;
            }
        }
        if constexpr (ALIGN_EPI) { if (wr == 0) PG8_BAR; }
        if constexpr (!Epi::AFTER_DRAIN) { E(acc, cur, wr, wc, fr, fq); S.done(cur); }
        if (!has_next) break;
#pragma unroll
        for (int a = 0; a < 2; ++a)
#pragma unroll
            for (int b = 0; b < 2; ++b)
#pragma unroll
                for (int m = 0; m < 4; ++m)
#pragma unroll
                    for (int n = 0; n < 2; ++n) acc[a][b][m][n] = (f32x4){0.f, 0.f, 0.f, 0.f};
        cur = nxt; cA = nA; cB = nB; ++ui;
        if constexpr (ALIGN_EPI) { if (wr == 1) PG8_BAR; }
    }
    PG8_WAIT_V(0);
    if constexpr (!ALIGN_EPI) { if (wr == 0) PG8_BAR; }
    PG8_BAR;
    if constexpr (Epi::AFTER_DRAIN) { E.fused(acc, cur, wr, wc, fr, fq, lds, wid, lane); S.done(cur); }
#undef PG8_SA
#undef PG8_SB
#undef PG8_STAGE
#undef PG8_LDA
#undef PG8_LDB
#undef PG8_MMA
#undef PG8_WAIT_V
#undef PG8_WAIT_L
#undef PG8_BAR
#undef PG8_SCHED
}
}

#define LAS __attribute__((address_space(3)))
typedef unsigned short bf16;
typedef unsigned v4u __attribute__((ext_vector_type(4)));
typedef unsigned v2u __attribute__((ext_vector_type(2)));
typedef float f32x4 __attribute__((ext_vector_type(4)));
typedef float f32x16 __attribute__((ext_vector_type(16)));
typedef short bf16x8 __attribute__((ext_vector_type(8)));
typedef short s16x4 __attribute__((ext_vector_type(4)));
#define LDS_WAIT() asm volatile("s_waitcnt lgkmcnt(0)" ::: "memory")

constexpr int T_ = 32768, S_ = 8192, D_ = 1024, NW = 8, NTHR = 512;
constexpr size_t MiB = 1u << 20, REG = 64 * MiB;
constexpr size_t RGN(int i) { return (size_t)i * REG; }
constexpr size_t MISC = 7 * REG;
constexpr size_t O_WIN0 = MISC + 0 * MiB, O_WQKV = MISC + 4 * MiB, O_WPOOL = MISC + 6 * MiB, O_WOUTAB = MISC + 7 * MiB, O_WINC = MISC + 9 * MiB, O_WOUTC = MISC + 17 * MiB,
                 O_ROPE = MISC + 19 * MiB, O_G = MISC + 23 * MiB, O_BETA = MISC + 24 * MiB, O_GL = MISC + 25 * MiB, O_BAR = MISC + 26 * MiB, WS_NEED = MISC + 27 * MiB;
constexpr int LDS_BYTES = 147456;
constexpr int P0LD = 2176;
constexpr size_t O_QKV = 3 * REG + 16 * MiB;
constexpr float EPS = 1e-6f;

__device__ __forceinline__ float bflo(unsigned u) { return __builtin_bit_cast(float, u << 16); }
__device__ __forceinline__ float bfhi(unsigned u) { return __builtin_bit_cast(float, u & 0xffff0000u); }
__device__ __forceinline__ float bf1(bf16 b) { return __builtin_bit_cast(float, (unsigned)b << 16); }
__device__ __forceinline__ unsigned f2bf(float f) { unsigned u = __builtin_bit_cast(unsigned, f); return (u + 0x7fffu + ((u >> 16) & 1u)) >> 16; }
typedef __bf16 hwbf16x2 __attribute__((ext_vector_type(2)));
typedef float f32x2v __attribute__((ext_vector_type(2)));
__device__ __forceinline__ unsigned pk2(float lo, float hi) { const f32x2v v = {lo, hi}; return __builtin_bit_cast(unsigned, __builtin_convertvector(v, hwbf16x2)); }
__device__ __forceinline__ float row16_sum(float v) {
    v += __builtin_bit_cast(float, __builtin_amdgcn_update_dpp(0, __builtin_bit_cast(int, v), 0x128, 0xf, 0xf, false));
    v += __builtin_bit_cast(float, __builtin_amdgcn_update_dpp(0, __builtin_bit_cast(int, v), 0x124, 0xf, 0xf, false));
    v += __builtin_bit_cast(float, __builtin_amdgcn_update_dpp(0, __builtin_bit_cast(int, v), 0x122, 0xf, 0xf, false));
    v += __builtin_bit_cast(float, __builtin_amdgcn_update_dpp(0, __builtin_bit_cast(int, v), 0x121, 0xf, 0xf, false));
    return v;
}
__device__ __forceinline__ float wave_sum(float v) { v = row16_sum(v); v += __shfl_xor(v, 16); v += __shfl_xor(v, 32); return v; }
__device__ __forceinline__ float silu(float z) { return z * __builtin_amdgcn_rcpf(1.f + __expf(-z)); }


struct Args { const void* in[19]; float* out; unsigned char* ws; float inv_freq[16]; int ph_lo, ph_hi, dry, pad; };

__device__ __forceinline__ void transpose_item(const float* W, int ldw, bf16* WT, int ldt, int k0, int n0, int trow0, int tcol0, LAS float* scr, int lane) {
#pragma unroll 8
    for (int i = 0; i < 32; ++i) { const int kk = 2 * i + (lane >> 5); scr[kk * 33 + (lane & 31)] = __builtin_nontemporal_load(W + (size_t)(k0 + kk) * ldw + n0 + (lane & 31)); }
    LDS_WAIT();
    const int c = lane & 7;
#pragma unroll
    for (int j = 0; j < 4; ++j) { const int n = (lane >> 3) + 8 * j; const LAS float* s = scr + (8 * c) * 33 + n;
        v4u o; o.x = pk2(s[0 * 33], s[1 * 33]); o.y = pk2(s[2 * 33], s[3 * 33]); o.z = pk2(s[4 * 33], s[5 * 33]); o.w = pk2(s[6 * 33], s[7 * 33]);
        *(v4u*)(WT + (size_t)(trow0 + n) * ldt + tcol0 + 8 * c) = o; }
    LDS_WAIT();
}
__device__ __forceinline__ void transpose_job(const float* W, int ldw, int Nuse, bf16* WT, int ldt, int n_off, int k_off, int item, LAS float* scr, int lane) {
    const int nblk = Nuse / 32, kb = item / nblk, nb = item % nblk;
    transpose_item(W, ldw, WT, ldt, 64 * kb, 32 * nb, n_off + 32 * nb, k_off + 64 * kb, scr, lane);
}

__device__ __forceinline__ void p0_prologue(const Args& a, LAS unsigned char* lds) {
    const int tid = threadIdx.x, lane = tid & 63, wave = tid >> 6;
    const int gw = blockIdx.x * NW + wave, NGW = gridDim.x * NW;
    unsigned char* ws = a.ws;
    LAS float* scr = (LAS float*)(lds + wave * 16384);
    bf16* WIN0 = (bf16*)(ws + O_WIN0); bf16* WQKV = (bf16*)(ws + O_WQKV); bf16* WPOOL = (bf16*)(ws + O_WPOOL); bf16* WOUTAB = (bf16*)(ws + O_WOUTAB);
    bf16* WINC = (bf16*)(ws + O_WINC); bf16* WOUTC = (bf16*)(ws + O_WOUTC);
    constexpr int I0 = 16 * 61, I1 = 4 * 24, I2 = 2 * 32, I3 = 4 * 8, I4 = 16 * 32, I5 = 16 * 128, I6 = 16 * 32, NIT = I0 + I1 + I2 + I3 + I4 + I5 + I6;
    for (int it = gw; it < NIT; it += NGW) {
        int r = it;
        if (r < I0) { transpose_job((const float*)a.in[3], 1952, 1952, WIN0, 1024, 0, 0, r, scr, lane); continue; } r -= I0;
        if (r < I1) { transpose_job((const float*)a.in[5], 768, 768, WQKV, 384, 0, 0, r, scr, lane); continue; } r -= I1;
        if (r < I2) { transpose_job((const float*)a.in[7], 1024, 1024, WQKV, 384, 768, 256, r, scr, lane); continue; } r -= I2;
        if (r < I3) { const int g = r >> 3; transpose_job((const float*)a.in[8] + (size_t)g * 128 * 128, 128, 128, WPOOL, 512, g * 128, g * 128, r & 7, scr, lane); continue; } r -= I3;
        if (r < I4) { transpose_job((const float*)a.in[10], 1024, 1024, WOUTAB, 1024, 0, 0, r, scr, lane); continue; } r -= I4;
        if (r < I5) { transpose_job((const float*)a.in[12], 4112, 4096, WINC, 1024, 0, 0, r, scr, lane); continue; } r -= I5;
        transpose_job((const float*)a.in[17], 1024, 1024, WOUTC, 1024, 0, 0, r, scr, lane);
    }
    const int gt = blockIdx.x * NTHR + tid, NGT = gridDim.x * NTHR;
    const v4u z4 = {0u, 0u, 0u, 0u};
    for (int i = gt; i < 96 * 128; i += NGT) *(v4u*)(WIN0 + (size_t)1952 * 1024 + (size_t)i * 8) = z4;
    for (int i = gt; i < 1792 * 48; i += NGT) { const int row = i / 48, c8 = (i % 48) * 8; const bool isq = row < 768; const bool zero = isq ? (c8 >= 256) : (c8 < 256); if (zero) *(v4u*)(WQKV + (size_t)row * 384 + c8) = z4; }
    for (int i = gt; i < 512 * 64; i += NGT) { const int row = i / 64, c8 = (i % 64) * 8; if ((row >> 7) != (c8 >> 7)) *(v4u*)(WPOOL + (size_t)row * 512 + c8) = z4; }
    { float2* rope = (float2*)(ws + O_ROPE); const int* pos = (const int*)a.in[1];
      for (int i = gt; i < T_ * 16; i += NGT) { const int t = i >> 4, f = i & 15; const float ang = (float)pos[t] * a.inv_freq[f];
          const float C_HI = 0.15915494f, C_LO = 3.0908620e-9f;
          const float rev = ang * C_HI; const float err = fmaf(ang, C_HI, -rev) + ang * C_LO; const float fr = (rev - rintf(rev)) + err;
          rope[i] = make_float2(__builtin_amdgcn_cosf(fr), __builtin_amdgcn_sinf(fr)); } }
    { const float* x = (const float*)a.in[0]; const float* g = (const float*)a.in[2]; bf16* XN = (bf16*)(ws + RGN(0));
      f32x4 gv[4];
#pragma unroll
      for (int j = 0; j < 4; ++j) gv[j] = *(const f32x4*)(g + 4 * lane + 256 * j);
      f32x4 nv[4];
      { const f32x4* xr = (const f32x4*)(x + (size_t)(gw < T_ ? gw : 0) * D_) + lane;
#pragma unroll
        for (int j = 0; j < 4; ++j) nv[j] = __builtin_nontemporal_load(xr + 64 * j); }
      for (int m = gw; m < T_; m += NGW) {
          f32x4 v[4]; float s = 0.f;
          { const int mn = (m + NGW < T_) ? m + NGW : m; const f32x4* xn = (const f32x4*)(x + (size_t)mn * D_) + lane;
#pragma unroll
            for (int j = 0; j < 4; ++j) { v[j] = nv[j]; nv[j] = __builtin_nontemporal_load(xn + 64 * j); } }
#pragma unroll
          for (int j = 0; j < 4; ++j) s += (v[j].x * v[j].x + v[j].y * v[j].y) + (v[j].z * v[j].z + v[j].w * v[j].w);
          const float rs = rsqrtf(wave_sum(s) * (1.f / D_) + EPS);
          v2u* o8 = (v2u*)(XN + (size_t)m * D_) + lane;
#pragma unroll
          for (int j = 0; j < 4; ++j) { v2u o; o.x = pk2(v[j].x * rs * gv[j].x, v[j].y * rs * gv[j].y); o.y = pk2(v[j].z * rs * gv[j].z, v[j].w * rs * gv[j].w); o8[64 * j] = o; }
      } }
}

__device__ __forceinline__ void p2_prep(const Args& a) {
    const int tid = threadIdx.x, lane = tid & 63, wave = tid >> 6;
    const int gw = blockIdx.x * NW + wave, NGW = gridDim.x * NW;
    unsigned char* ws = a.ws;
    const bf16* proj0 = (const bf16*)(ws + RGN(1));
    bf16* A2 = (bf16*)(ws + RGN(5)); bf16* KR = (bf16*)(ws + RGN(5) + 24 * MiB); bf16* DP = (bf16*)(ws + RGN(5) + 26 * MiB);
    const float2* rope = (const float2*)(ws + O_ROPE);
    const f32x4 qg = *(const f32x4*)((const float*)a.in[4] + 4 * lane);
    const float2 kg = *(const float2*)((const float*)a.in[6] + 2 * lane);
    for (int t = gw; t < T_; t += NGW) {
        const bf16* pr = proj0 + (size_t)t * P0LD;
        { const v2u q = *(const v2u*)(pr + 4 * lane); const float q0 = bflo(q.x), q1 = bfhi(q.x), q2 = bflo(q.y), q3 = bfhi(q.y);
          const float rs = rsqrtf(wave_sum((q0 * q0 + q1 * q1) + (q2 * q2 + q3 * q3)) * (1.f / 256.f) + EPS);
          v2u o; o.x = pk2(q0 * rs * qg.x, q1 * rs * qg.y); o.y = pk2(q2 * rs * qg.z, q3 * rs * qg.w); *(v2u*)(A2 + (size_t)t * 384 + 4 * lane) = o; }
        { const unsigned k = *(const unsigned*)(pr + 256 + 2 * lane); const float k0 = bflo(k), k1 = bfhi(k);
          const float rs = rsqrtf(wave_sum(k0 * k0 + k1 * k1) * (1.f / 128.f) + EPS);
          *(unsigned*)(A2 + (size_t)t * 384 + 256 + 2 * lane) = pk2(k0 * rs * kg.x, k1 * rs * kg.y); }
        if (lane < 16) { const float x1 = bf1(pr[384 + lane]), x2 = bf1(pr[400 + lane]); const float2 cs = rope[(size_t)t * 16 + lane];
          *(unsigned*)(KR + (size_t)t * 32 + 2 * lane) = pk2(x1 * cs.x - x2 * cs.y, x2 * cs.x + x1 * cs.y); }
        { const int g = lane >> 4, w = 2 << g, ts = t & (S_ - 1), cnt = min(ts + 1, w);
          float acc[8];
#pragma unroll
          for (int e = 0; e < 8; ++e) acc[e] = 0.f;
          v4u wv[16];
#pragma unroll
          for (int j = 0; j < 16; ++j) { const int jj = (j < cnt) ? j : 0; wv[j] = *(const v4u*)(pr - (size_t)jj * P0LD + 416 + 8 * lane); }
          float x0[8];
#pragma unroll
          for (int j = 0; j < 16; ++j) { const v4u v = wv[j]; const float mk = (j < cnt) ? 1.f : 0.f;
              const float f[8] = {bflo(v.x), bfhi(v.x), bflo(v.y), bfhi(v.y), bflo(v.z), bfhi(v.z), bflo(v.w), bfhi(v.w)};
#pragma unroll
              for (int e = 0; e < 8; ++e) { acc[e] = fmaf(f[e], mk, acc[e]); if (j == 0) x0[e] = f[e]; }
          }
          const float ic = 1.f / (float)cnt; v4u o;
          o.x = pk2(acc[0] * ic - x0[0], acc[1] * ic - x0[1]); o.y = pk2(acc[2] * ic - x0[2], acc[3] * ic - x0[3]);
          o.z = pk2(acc[4] * ic - x0[4], acc[5] * ic - x0[5]); o.w = pk2(acc[6] * ic - x0[6], acc[7] * ic - x0[7]);
          *(v4u*)(DP + (size_t)t * 512 + 8 * lane) = o; }
    }
}

constexpr int KROW = 208, KBYTES = 64 * KROW, VBYTES = 8192;
typedef short v4i16_t __attribute__((ext_vector_type(4)));
__device__ __forceinline__ s16x4 vtr(const LAS unsigned char* p) { return __builtin_bit_cast(s16x4, __builtin_amdgcn_ds_read_tr16_b64_v4i16((LAS v4i16_t*)p)); }
__device__ __forceinline__ bf16x8 cat8(s16x4 lo, s16x4 hi) { bf16x8 r; r[0] = lo[0]; r[1] = lo[1]; r[2] = lo[2]; r[3] = lo[3]; r[4] = hi[0]; r[5] = hi[1]; r[6] = hi[2]; r[7] = hi[3]; return r; }
__device__ __forceinline__ bf16x8 pack8(float a0, float a1, float a2, float a3, float a4, float a5, float a6, float a7) {
    v4u u; u.x = pk2(a0, a1); u.y = pk2(a2, a3); u.z = pk2(a4, a5); u.w = pk2(a6, a7); return __builtin_bit_cast(bf16x8, u); }

__device__ __forceinline__ void attn_unit(LAS unsigned char* lds, int b, int h, int qb, const bf16* qkv, const bf16* KR, const float2* rope, const bf16* proj0, bf16* Y) {
    int tid = threadIdx.x; asm volatile("" : "+v"(tid));
    const int lane = tid & 63, wave = __builtin_amdgcn_readfirstlane(tid >> 6), r = lane & 31, hh = lane >> 5;
    const int q0 = qb * 256, myq = q0 + 32 * wave + r;
    const size_t tq = (size_t)b * S_ + myq;
    const float CS = 0.10206207261596577f * 1.4426950408889634f;
    bf16x8 Qf[6];
    { const bf16* qp = qkv + tq * 1792 + h * 96;
#pragma unroll
      for (int s = 0; s < 4; ++s) Qf[s] = __builtin_nontemporal_load((const bf16x8*)(qp + 16 * s + 8 * hh));
#pragma unroll
      for (int s2 = 0; s2 < 2; ++s2) { const int i0 = 8 * s2 + 4 * hh;
          const v2u xa = *(const v2u*)(qp + 64 + i0), xb = *(const v2u*)(qp + 80 + i0);
          const f32x4 c0 = *(const f32x4*)(rope + tq * 16 + i0), c1 = *(const f32x4*)(rope + tq * 16 + i0 + 2);
          const float a0 = bflo(xa.x), a1 = bfhi(xa.x), a2 = bflo(xa.y), a3 = bfhi(xa.y), b0 = bflo(xb.x), b1 = bfhi(xb.x), b2 = bflo(xb.y), b3 = bfhi(xb.y);
          Qf[4 + s2] = pack8(a0 * c0.x - b0 * c0.y, b0 * c0.x + a0 * c0.y, a1 * c0.z - b1 * c0.w, b1 * c0.z + a1 * c0.w,
                             a2 * c1.x - b2 * c1.y, b2 * c1.x + a2 * c1.y, a3 * c1.z - b3 * c1.w, b3 * c1.z + a3 * c1.w); } }
    const int skey = tid >> 3, sch = tid & 7, rkey = tid >> 2, rch = tid & 3;
    const bf16* kvbase = qkv + ((size_t)b * S_) * 1792 + 768 + h * 128;
    const bf16* krbase = KR + ((size_t)b * S_) * 32;
    constexpr int KB2 = 128 * KROW, VB2 = 2 * VBYTES, VOFF = 2 * KB2;
    const int NT = 2 * (qb + 1);
    const int qhi = q0 + 32 * wave + 31, qlo = q0 + 32 * wave;
    v4u gk0, gk1, gr, gv0, gv1;
#define ATT_LDK(T_) do { const size_t kk_ = (size_t)(T_) * 128; \
        gk0 = *(const v4u*)(kvbase + (kk_ + skey) * 1792 + sch * 8); gk1 = *(const v4u*)(kvbase + (kk_ + 64 + skey) * 1792 + sch * 8); \
        gr = *(const v4u*)(krbase + (kk_ + rkey) * 32 + rch * 8); } while (0)
#define ATT_LDV(T_) do { const size_t kk_ = (size_t)(T_) * 128; \
        gv0 = *(const v4u*)(kvbase + (kk_ + skey) * 1792 + 64 + sch * 8); gv1 = *(const v4u*)(kvbase + (kk_ + 64 + skey) * 1792 + 64 + sch * 8); } while (0)
#define ATT_LD(T_) do { ATT_LDK(T_); ATT_LDV(T_); } while (0)
#define ATT_STK(buf) do { LAS unsigned char* Kn_ = lds + (buf) * KB2; \
        *(LAS v4u*)(Kn_ + skey * KROW + sch * 16) = gk0; *(LAS v4u*)(Kn_ + (64 + skey) * KROW + sch * 16) = gk1; *(LAS v4u*)(Kn_ + rkey * KROW + 128 + rch * 16) = gr; } while (0)
#define ATT_STV(buf) do { LAS unsigned char* Vn_ = lds + VOFF + (buf) * VB2; \
        *(LAS v4u*)(Vn_ + (sch >> 2) * 4096 + skey * 64 + (sch & 3) * 16) = gv0; *(LAS v4u*)(Vn_ + VBYTES + (sch >> 2) * 4096 + skey * 64 + (sch & 3) * 16) = gv1; } while (0)
#define ATT_ST(buf) do { ATT_STK(buf); ATT_STV(buf); } while (0)
#define ATT_QK(dst0, dst1, Kb_) do { \
        _Pragma("unroll") for (int i_ = 0; i_ < 16; ++i_) { dst0[i_] = 0.f; dst1[i_] = 0.f; } \
        _Pragma("unroll") for (int s_ = 0; s_ < 6; ++s_) { \
            const bf16x8 ka_ = *(const LAS bf16x8*)((Kb_) + r * KROW + (16 * s_ + 8 * hh) * 2); const bf16x8 kb_ = *(const LAS bf16x8*)((Kb_) + (32 + r) * KROW + (16 * s_ + 8 * hh) * 2); \
            dst0 = __builtin_amdgcn_mfma_f32_32x32x16_bf16(ka_, Qf[s_], dst0, 0, 0, 0); dst1 = __builtin_amdgcn_mfma_f32_32x32x16_bf16(kb_, Qf[s_], dst1, 0, 0, 0); } } while (0)
#define ATT_SMPV(s0, s1, kbase_, Vb_, GEN, FIRST) do { \
        if (GEN) { \
            if ((kbase_) + 63 > qlo) { \
                _Pragma("unroll") for (int i = 0; i < 16; ++i) { const int key = (kbase_) + 8 * (i >> 2) + 4 * hh + (i & 3); \
                    if (key > myq) s0[i] = -INFINITY; if (key + 32 > myq) s1[i] = -INFINITY; } } \
            if (FIRST) { float mx = fmaxf(s0[0], s1[0]); \
                _Pragma("unroll") for (int i = 1; i < 16; ++i) mx = fmaxf(mx, fmaxf(s0[i], s1[i])); \
                m_run = fmaxf(mx, __shfl_xor(mx, 32)); } \
        } \
        const float nm = -m_run * CS; float ps = 0.f; \
        _Pragma("unroll") for (int i = 0; i < 16; ++i) { s0[i] = __builtin_amdgcn_exp2f(fmaf(s0[i], CS, nm)); s1[i] = __builtin_amdgcn_exp2f(fmaf(s1[i], CS, nm)); ps += s0[i] + s1[i]; } \
        l_run += ps; \
        const bf16x8 P00 = pack8(s0[0], s0[1], s0[2], s0[3], s0[4], s0[5], s0[6], s0[7]); \
        const bf16x8 P01 = pack8(s0[8], s0[9], s0[10], s0[11], s0[12], s0[13], s0[14], s0[15]); \
        const bf16x8 P10 = pack8(s1[0], s1[1], s1[2], s1[3], s1[4], s1[5], s1[6], s1[7]); \
        const bf16x8 P11 = pack8(s1[8], s1[9], s1[10], s1[11], s1[12], s1[13], s1[14], s1[15]); \
        _Pragma("unroll") for (int ks = 0; ks < 4; ++ks) { \
            const bf16x8 P = ks == 0 ? P00 : ks == 1 ? P01 : ks == 2 ? P10 : P11; \
            const LAS unsigned char* vp = (Vb_) + (16 * ks) * 64 + troff; \
            const bf16x8 va0 = cat8(vtr(vp), vtr(vp + 8 * 64)); \
            const bf16x8 va1 = cat8(vtr(vp + 4096), vtr(vp + 4096 + 8 * 64)); \
            o0 = __builtin_amdgcn_mfma_f32_32x32x16_bf16(va0, P, o0, 0, 0, 0); \
            o1 = __builtin_amdgcn_mfma_f32_32x32x16_bf16(va1, P, o1, 0, 0, 0); } } while (0)
#define ATT_ITER(GEN) do { \
        const int kb0 = T * 128; \
        const int Tn = T + 1 < NT ? T + 1 : T; ATT_LDK(Tn); \
        const LAS unsigned char* Kb = lds + (T & 1) * KB2; const LAS unsigned char* Vb = lds + VOFF + (T & 1) * VB2; \
        const bool actA = !(GEN) || (kb0 <= qhi), actB = !(GEN) || (kb0 + 64 <= qhi); \
        if (actA) ATT_QK(a0, a1, Kb); \
        if (actB) ATT_QK(b0, b1, Kb + 64 * KROW); \
        ATT_STK((T + 1) & 1); ATT_LDV(Tn); \
        if (actA) ATT_SMPV(a0, a1, kb0, Vb, GEN, T == 0); \
        if (actB) ATT_SMPV(b0, b1, kb0 + 64, Vb + VBYTES, GEN, false); \
        ATT_STV((T + 1) & 1); \
        __syncthreads(); } while (0)
    f32x16 o0, o1, a0, a1, b0, b1; float m_run = -INFINITY, l_run = 0.f;
#pragma unroll
    for (int i = 0; i < 16; ++i) { o0[i] = 0.f; o1[i] = 0.f; }
    const int g4 = lane >> 4, tq_ = (lane & 15) >> 2, tp = lane & 3;
    const int troff = (4 * hh + tq_) * 64 + (16 * (g4 & 1) + 4 * tp) * 2;
    ATT_LD(0); ATT_ST(0);
    __syncthreads();
    int T = 0;
    ATT_ITER(true);
    for (T = 1; T < 2 * qb; ++T) ATT_ITER(false);
    for (; T < NT; ++T) ATT_ITER(true);
#undef ATT_LD
#undef ATT_LDK
#undef ATT_LDV
#undef ATT_ST
#undef ATT_STK
#undef ATT_STV
#undef ATT_QK
#undef ATT_SMPV
#undef ATT_ITER
    const float lt = l_run + __shfl_xor(l_run, 32), inv = 1.f / lt;
    const bf16* zp = proj0 + tq * P0LD + 928 + h * 64; bf16* yp = Y + tq * 1024 + h * 64;
#pragma unroll
    for (int c = 0; c < 2; ++c)
#pragma unroll
        for (int gq = 0; gq < 4; ++gq) { const int dv = 32 * c + 8 * gq + 4 * hh;
            const v2u z = __builtin_nontemporal_load((const v2u*)(zp + dv));
            const float v0 = (c ? o1[4 * gq + 0] : o0[4 * gq + 0]) * inv, v1 = (c ? o1[4 * gq + 1] : o0[4 * gq + 1]) * inv, v2 = (c ? o1[4 * gq + 2] : o0[4 * gq + 2]) * inv, v3 = (c ? o1[4 * gq + 3] : o0[4 * gq + 3]) * inv;
            v2u o; o.x = pk2(v0 * silu(bflo(z.x)), v1 * silu(bfhi(z.x))); o.y = pk2(v2 * silu(bflo(z.y)), v3 * silu(bfhi(z.y)));
            *(v2u*)(yp + dv) = o; }
}

__device__ __forceinline__ void p4_attn(const Args& a, LAS unsigned char* lds) {
    unsigned char* ws = a.ws;
    const bf16* proj0 = (const bf16*)(ws + RGN(1)); const bf16* qkv = (const bf16*)(ws + O_QKV); const bf16* KR = (const bf16*)(ws + RGN(5) + 24 * MiB);
    const bf16* YB = (const bf16*)(ws + RGN(6)); bf16* Y = (bf16*)(ws + RGN(0)); const float2* rope = (const float2*)(ws + O_ROPE);
    for (int it = blockIdx.x; it < 512; it += gridDim.x) {
        const int xcd = it & 7, j = it >> 3, bh = xcd * 4 + (j & 3), pr = j >> 2, b = bh >> 3, h = bh & 7;
#pragma unroll 1
        for (int u = 0; u < 2; ++u) attn_unit(lds, b, h, u ? 31 - pr : pr, qkv, KR, rope, proj0, Y);
    }
}

#define XB_TMO      128
#define XB_XCNT(j)  (256  + 64 * (j))
#define XB_XSUB(j)  (1280 + 64 * (j))
#define XB_XGEN(j)  (2304 + 64 * (j))
#define XB_TOP      3328
#define XB_TOPGEN   3392
#define XCD_BAR_WORDS 3456
#define XB_SPIN_CAP (1u << 18)

__device__ __forceinline__ unsigned xb_ld(unsigned* p)              { return __hip_atomic_load(p, __ATOMIC_RELAXED, __HIP_MEMORY_SCOPE_AGENT); }
__device__ __forceinline__ unsigned xb_add(unsigned* p, unsigned v) { return __hip_atomic_fetch_add(p, v, __ATOMIC_RELAXED, __HIP_MEMORY_SCOPE_AGENT); }
__device__ __forceinline__ unsigned xb_xcc_id() { return (unsigned)__builtin_amdgcn_s_getreg((3 << 11) | 20) & 0xFu; }
#define XB_SPIN(cond, bar) do { unsigned _sp = 0; while (cond) { __builtin_amdgcn_s_sleep(1); \
    if ((++_sp & 255u) == 0u) { if (xb_ld(&(bar)[XB_TMO])) break; if (_sp > XB_SPIN_CAP) { atomicAdd(&(bar)[XB_TMO], 1u); break; } } } } while (0)

struct XcdBarrier {
    unsigned* bar; unsigned x;
    volatile LAS unsigned* st;
};

__device__ __forceinline__ XcdBarrier xcd_barrier_post(unsigned* bar, volatile LAS unsigned* st) {
    XcdBarrier b; b.bar = bar; b.x = xb_xcc_id(); b.st = st;
    if (threadIdx.x == 0) (void)xb_add(&bar[XB_XCNT(b.x)], 1u);
    return b;
}
__device__ __forceinline__ void xcd_barrier_complete(unsigned* bar, unsigned x, unsigned& nloc, unsigned& nx) {
    const unsigned G = gridDim.x * gridDim.y * gridDim.z;
    unsigned sum, cnt, mine, sp = 0u;
    for (;;) {
        sum = 0u; cnt = 0u; mine = 0u;
#pragma unroll
        for (unsigned j = 0; j < 16; ++j) { const unsigned c = xb_ld(&bar[XB_XCNT(j)]); sum += c; cnt += (c > 0u) ? 1u : 0u; mine = (j == x) ? c : mine; }
        if (sum == G) break;
        __builtin_amdgcn_s_sleep(1);
        if ((++sp & 255u) == 0u) { if (xb_ld(&bar[XB_TMO])) break; if (sp > XB_SPIN_CAP) { atomicAdd(&bar[XB_TMO], 1u); break; } }
    }
    nloc = mine > 0u ? mine : 1u; nx = cnt > 0u ? cnt : 1u;
}

__device__ __forceinline__ void xcd_barrier(const XcdBarrier& b) {
    asm volatile("s_waitcnt vmcnt(0)" ::: "memory");
    __syncthreads();
    if (threadIdx.x == 0) {
        unsigned* bar = b.bar;
        __builtin_amdgcn_s_waitcnt(0);
        unsigned nloc = b.st[0], nx = b.st[1];
        if (nloc == 0u) { xcd_barrier_complete(bar, b.x, nloc, nx); b.st[0] = nloc; b.st[1] = nx; }
        const unsigned old = xb_add(&bar[XB_XSUB(b.x)], 1u);
        const unsigned gen = old / nloc;
        if (old + 1u == (gen + 1u) * nloc) {
            __builtin_amdgcn_fence(__ATOMIC_RELEASE, "agent");
            asm volatile("s_waitcnt vmcnt(0)" ::: "memory");
            const unsigned og = xb_add(&bar[XB_TOP], 1u);
            const unsigned tg = og / nx;
            if (og + 1u == (tg + 1u) * nx) xb_add(&bar[XB_TOPGEN], 1u);
            else XB_SPIN(xb_ld(&bar[XB_TOPGEN]) == tg, bar);
            __builtin_amdgcn_fence(__ATOMIC_ACQUIRE, "agent");
            xb_add(&bar[XB_XGEN(b.x)], 1u);
            asm volatile("s_waitcnt vmcnt(0)" ::: "memory");
        } else {
            XB_SPIN(xb_ld(&bar[XB_XGEN(b.x)]) == gen, bar);
            __builtin_amdgcn_fence(__ATOMIC_ACQUIRE, "agent");
            asm volatile("s_waitcnt vmcnt(0)" ::: "memory");
        }
    }
    __syncthreads();
}


__device__ __forceinline__ void p6_norm_ab(const Args& a, LAS unsigned char* lds) {
    const int tid = threadIdx.x, lane = tid & 63, wave = tid >> 6;
    const int gw = blockIdx.x * NW + wave, NGW = gridDim.x * NW;
    unsigned char* ws = a.ws;
    LAS float* Wl = (LAS float*)lds;
    { const float* wc = (const float*)a.in[12];
      for (int i = tid; i < 16 * 1024; i += NTHR) { const int k = i >> 4, c = i & 15; Wl[c * 1024 + k] = wc[(size_t)k * 4112 + 4096 + c]; } }
    __syncthreads();
    const float* X = (const float*)a.in[0]; const bf16* DL = (const bf16*)(ws + RGN(1)); float* H1 = a.out; const float* g = (const float*)a.in[11]; bf16* XN = (bf16*)(ws + RGN(0));
    float* Gb = (float*)(ws + O_G); float* Bb = (float*)(ws + O_BETA);
    const float* alog = (const float*)a.in[14]; const float* dtb = (const float*)a.in[15];
    f32x4 gv[4];
#pragma unroll
    for (int j = 0; j < 4; ++j) gv[j] = *(const f32x4*)(g + 4 * lane + 256 * j);
    f32x4 nv[4]; v2u nd[4];
    { const int m0 = gw < T_ ? gw : 0; const f32x4* xr = (const f32x4*)(X + (size_t)m0 * D_) + lane; const v2u* dr = (const v2u*)(DL + (size_t)m0 * D_) + lane;
#pragma unroll
      for (int j = 0; j < 4; ++j) { nv[j] = __builtin_nontemporal_load(xr + 64 * j); nd[j] = __builtin_nontemporal_load(dr + 64 * j); } }
    for (int m = gw; m < T_; m += NGW) {
        f32x4 v[4]; float s = 0.f;
        { const int mn = (m + NGW < T_) ? m + NGW : m; const f32x4* xn = (const f32x4*)(X + (size_t)mn * D_) + lane; const v2u* dn = (const v2u*)(DL + (size_t)mn * D_) + lane;
#pragma unroll
          for (int j = 0; j < 4; ++j) { v[j].x = nv[j].x + bflo(nd[j].x); v[j].y = nv[j].y + bfhi(nd[j].x); v[j].z = nv[j].z + bflo(nd[j].y); v[j].w = nv[j].w + bfhi(nd[j].y); nv[j] = __builtin_nontemporal_load(xn + 64 * j); nd[j] = __builtin_nontemporal_load(dn + 64 * j); } }
        { f32x4* hw = (f32x4*)(H1 + (size_t)m * D_) + lane;
#pragma unroll
          for (int j = 0; j < 4; ++j) __builtin_nontemporal_store(v[j], hw + 64 * j); }
#pragma unroll
        for (int j = 0; j < 4; ++j) s += (v[j].x * v[j].x + v[j].y * v[j].y) + (v[j].z * v[j].z + v[j].w * v[j].w);
        const float rs = rsqrtf(wave_sum(s) * (1.f / D_) + EPS);
        v2u* o8 = (v2u*)(XN + (size_t)m * D_) + lane;
#pragma unroll
        for (int j = 0; j < 4; ++j) { v[j] = v[j] * rs * gv[j]; v2u o; o.x = pk2(v[j].x, v[j].y); o.y = pk2(v[j].z, v[j].w); o8[64 * j] = o; }
        asm volatile("" ::: "memory");
        float acc[16];
#pragma unroll
        for (int c = 0; c < 16; ++c) { float s2 = 0.f;
#pragma unroll
            for (int j = 0; j < 4; ++j) { const f32x4 w = *(const LAS f32x4*)(Wl + c * 1024 + 256 * j + 4 * lane); s2 += (v[j].x * w.x + v[j].y * w.y) + (v[j].z * w.z + v[j].w * w.w); }
            acc[c] = s2; }
        float r8[8], r4[4], r2[2], mine;
        { const bool hi = lane & 32;
#pragma unroll
          for (int c = 0; c < 8; ++c) { const float snd = hi ? acc[c] : acc[8 + c]; const float kp = hi ? acc[8 + c] : acc[c]; r8[c] = kp + __shfl_xor(snd, 32); } }
        { const bool hi = lane & 16;
#pragma unroll
          for (int c = 0; c < 4; ++c) { const float snd = hi ? r8[c] : r8[4 + c]; const float kp = hi ? r8[4 + c] : r8[c]; r4[c] = kp + __shfl_xor(snd, 16); } }
        { const bool hi = lane & 8;
#pragma unroll
          for (int c = 0; c < 2; ++c) { const float snd = hi ? r4[c] : r4[2 + c]; const float kp = hi ? r4[2 + c] : r4[c]; r2[c] = kp + __shfl_xor(snd, 8); } }
        { const bool hi = lane & 4; const float snd = hi ? r2[0] : r2[1]; const float kp = hi ? r2[1] : r2[0]; mine = kp + __shfl_xor(snd, 4); }
        mine += __shfl_xor(mine, 2); mine += __shfl_xor(mine, 1);
        const int colc = lane >> 2;
        if ((lane & 3) == 0) {
            if (colc < 8) { const float xx = mine + dtb[colc]; const float sp = fmaxf(xx, 0.f) + __logf(1.f + __expf(-fabsf(xx))); Gb[(size_t)m * 8 + colc] = -__expf(alog[colc]) * sp; }
            else { Bb[(size_t)m * 8 + colc - 8] = __builtin_amdgcn_rcpf(1.f + __expf(-mine)); } }
    }
}

__device__ __forceinline__ void p8a_conv(const Args& a) {
    const int tid = threadIdx.x, lane = tid & 63, wave = tid >> 6;
    const int gw = blockIdx.x * NW + wave, NGW = gridDim.x * NW;
    unsigned char* ws = a.ws; const float* cw = (const float*)a.in[13];
    for (int it = gw; it < 2048 * 6; it += NGW) {
        const int grp = it / 6, sub = it % 6, which = sub >> 1, half = sub & 1;
        const int col = half * 512 + 8 * lane, ch = which * 1024 + col;
        const bf16* src = (const bf16*)(ws + RGN(1 + which)); bf16* dst = (bf16*)(ws + (which == 0 ? RGN(5) : which == 1 ? RGN(6) : RGN(0)));
        const int t0 = grp * 16, ts0 = t0 & (S_ - 1);
        float w[4][8];
#pragma unroll
        for (int j = 0; j < 4; ++j) { const f32x4 w0 = *(const f32x4*)(cw + (size_t)j * 3072 + ch), w1 = *(const f32x4*)(cw + (size_t)j * 3072 + ch + 4);
            w[j][0] = w0.x; w[j][1] = w0.y; w[j][2] = w0.z; w[j][3] = w0.w; w[j][4] = w1.x; w[j][5] = w1.y; w[j][6] = w1.z; w[j][7] = w1.w; }
        v4u xr[19];
#pragma unroll
        for (int i = 0; i < 19; ++i) { const v4u z4 = {0u, 0u, 0u, 0u}; const bool ok = (i >= 3 || ts0 > 0); const int ti = ok ? t0 - 3 + i : t0;
            const v4u ld = __builtin_nontemporal_load((const v4u*)(src + (size_t)ti * 1024 + col)); xr[i] = ok ? ld : z4; }
#pragma unroll
        for (int o = 0; o < 16; ++o) {
            float y[8];
#pragma unroll
            for (int e = 0; e < 8; ++e) y[e] = 0.f;
#pragma unroll
            for (int j = 0; j < 4; ++j) { const v4u v = xr[o + j];
                y[0] += w[j][0] * bflo(v.x); y[1] += w[j][1] * bfhi(v.x); y[2] += w[j][2] * bflo(v.y); y[3] += w[j][3] * bfhi(v.y);
                y[4] += w[j][4] * bflo(v.z); y[5] += w[j][5] * bfhi(v.z); y[6] += w[j][6] * bflo(v.w); y[7] += w[j][7] * bfhi(v.w); }
            float ss = 0.f;
#pragma unroll
            for (int e = 0; e < 8; ++e) { y[e] = silu(y[e]); ss += y[e] * y[e]; }
            float sc = 1.f;
            if (which < 2) { ss = row16_sum(ss);
                sc = rsqrtf(ss + EPS); if (which == 0) sc *= 0.08838834764831845f; }
            v4u ov; ov.x = pk2(y[0] * sc, y[1] * sc); ov.y = pk2(y[2] * sc, y[3] * sc); ov.z = pk2(y[4] * sc, y[5] * sc); ov.w = pk2(y[6] * sc, y[7] * sc);
            *(v4u*)(dst + (size_t)(t0 + o) * 1024 + col) = ov;
        }
    }
}

constexpr int TS = 272, TILE = 17408, L_SET = 2 * TILE, L_M = 2 * L_SET, L_GC = L_M + 4 * TILE;
#define MFMA16(A, B, C) __builtin_amdgcn_mfma_f32_16x16x32_bf16(A, B, C, 0, 0, 0)
__device__ __forceinline__ void p8b_chunk(const Args& a, LAS unsigned char* lds) {
    const int tid0 = threadIdx.x;
    unsigned char* ws = a.ws;
    bf16* QN = (bf16*)(ws + RGN(5)); bf16* KN = (bf16*)(ws + RGN(6)); const bf16* VN = (const bf16*)(ws + RGN(0));
    bf16* KDT = (bf16*)(ws + RGN(1)); bf16* ATT = (bf16*)(ws + RGN(2)); bf16* UT = (bf16*)(ws + RGN(3));
    bf16* QOUT = a.dry ? KDT : QN; bf16* WOUT = a.dry ? UT : KN;
    const float* Gb = (const float*)(ws + O_G); const float* Bb = (const float*)(ws + O_BETA); float* GL = (float*)(ws + O_GL);
    for (int base = blockIdx.x * 4; base < 4096; base += gridDim.x * 4) {
        int tid = tid0; asm volatile("" : "+v"(tid));
        const int lane = tid & 63, wave = __builtin_amdgcn_readfirstlane(tid >> 6), c = lane & 15, g = lane >> 4;
        const int bh = base >> 7, b = bh >> 3, h = bh & 7;
        const size_t tokb = (size_t)b * S_ + (size_t)(base & 127) * 64;
        const int r0 = tid >> 4, ch = tid & 15;
        if (wave < 4) { LAS float* gcs = (LAS float*)(lds + L_GC + wave * 1024); const size_t t0 = tokb + wave * 64;
            float gv = Gb[(t0 + lane) * 8 + h];
#pragma unroll
            for (int o = 1; o < 64; o <<= 1) { const float t = __shfl_up(gv, o); if (lane >= o) gv += t; }
            const float g63 = __shfl(gv, 63);
            gcs[lane] = gv; gcs[64 + lane] = __expf(gv); gcs[128 + lane] = Bb[(t0 + lane) * 8 + h]; gcs[192 + lane] = __expf(g63 - gv);
            if (lane == 63) GL[base + wave] = __expf(gv); }
        v4u pa0, pa1, pb0, pb1;
        { const size_t go = (tokb + r0) * 1024 + h * 128 + ch * 8;
          pa0 = __builtin_nontemporal_load((const v4u*)(QN + go)); pa1 = __builtin_nontemporal_load((const v4u*)(QN + go + 32 * 1024)); pb0 = *(const v4u*)(KN + go); pb1 = *(const v4u*)(KN + go + 32 * 1024);
          *(LAS v4u*)(lds + r0 * TS + ch * 16) = pa0; *(LAS v4u*)(lds + (r0 + 32) * TS + ch * 16) = pa1;
          *(LAS v4u*)(lds + TILE + r0 * TS + ch * 16) = pb0; *(LAS v4u*)(lds + TILE + (r0 + 32) * TS + ch * 16) = pb1; }
        __syncthreads();
#pragma unroll 1
        for (int bc = 0; bc < 4; ++bc) {
            const int cidx = base + bc;
            if (bc < 3) { const size_t go = (tokb + (bc + 1) * 64 + r0) * 1024 + h * 128 + ch * 8;
                pa0 = __builtin_nontemporal_load((const v4u*)(QN + go)); pa1 = __builtin_nontemporal_load((const v4u*)(QN + go + 32 * 1024)); pb0 = *(const v4u*)(KN + go); pb1 = *(const v4u*)(KN + go + 32 * 1024); }
            const int sQ = (bc & 1) * L_SET, sK = sQ + TILE;
            LAS float* gcs = (LAS float*)(lds + L_GC + bc * 1024); LAS float* Ml = (LAS float*)(lds + L_M + bc * TILE);
#pragma unroll 1
            for (int rr = 0; rr < 4; ++rr) {
                const int tsk = wave + 8 * rr, isM = tsk >> 4, tt = tsk & 15, ib = tt >> 2, jb = tt & 3;
                const int i = 16 * ib + c, j0 = 16 * jb + 4 * g;
                const int aoff = ((ib * 2 + (jb >> 1)) * 64 + (2 * (jb & 1) + (g >> 1)) * 16 + c) * 8 + ((4 * g) & 7);
                if (jb <= ib) {
                    f32x4 acc = {0.f, 0.f, 0.f, 0.f};
                    const int xs = isM ? sK : sQ;
#pragma unroll
                    for (int ks = 0; ks < 4; ++ks) {
                        const bf16x8 A = *(const LAS bf16x8*)(lds + sK + (16 * jb + c) * TS + (32 * ks + 8 * g) * 2);
                        const bf16x8 B = *(const LAS bf16x8*)(lds + xs + (16 * ib + c) * TS + (32 * ks + 8 * g) * 2);
                        acc = MFMA16(A, B, acc); }
                    const float gi = gcs[i]; float e[4];
#pragma unroll
                    for (int ii = 0; ii < 4; ++ii) e[ii] = __expf(gi - gcs[j0 + ii]);
                    if (isM) { const float bi = gcs[128 + i]; f32x4 m;
                        m.x = (i > j0 + 0) ? bi * acc[0] * e[0] : 0.f; m.y = (i > j0 + 1) ? bi * acc[1] * e[1] : 0.f; m.z = (i > j0 + 2) ? bi * acc[2] * e[2] : 0.f; m.w = (i > j0 + 3) ? bi * acc[3] * e[3] : 0.f;
                        *(LAS f32x4*)(Ml + i * 68 + j0) = m;
                    } else { const float a0 = (i >= j0 + 0) ? acc[0] * e[0] : 0.f, a1 = (i >= j0 + 1) ? acc[1] * e[1] : 0.f, a2 = (i >= j0 + 2) ? acc[2] * e[2] : 0.f, a3 = (i >= j0 + 3) ? acc[3] * e[3] : 0.f;
                        v2u o; o.x = pk2(a0, a1); o.y = pk2(a2, a3); *(v2u*)(ATT + (size_t)cidx * 4096 + aoff) = o; }
                } else if (!isM) { const v2u o = {0u, 0u}; *(v2u*)(ATT + (size_t)cidx * 4096 + aoff) = o; }
                else { const f32x4 z = {0.f, 0.f, 0.f, 0.f}; *(LAS f32x4*)(Ml + i * 68 + j0) = z; }
            }
            for (int i2 = tid; i2 < 1024; i2 += NTHR) { const int row = i2 >> 4, cc = i2 & 15; const v4u v = *(const LAS v4u*)(lds + sQ + row * TS + cc * 16); const float e = gcs[64 + row]; v4u o;
                o.x = pk2(bflo(v.x) * e, bfhi(v.x) * e); o.y = pk2(bflo(v.y) * e, bfhi(v.y) * e); o.z = pk2(bflo(v.z) * e, bfhi(v.z) * e); o.w = pk2(bflo(v.w) * e, bfhi(v.w) * e);
                const int R = 4 * ((row >> 4) * 4 + (cc >> 2)) + (cc & 3), C = (row & 15) * 8;
                *(v4u*)(QOUT + (tokb + bc * 64 + R) * 1024 + h * 128 + C) = o; }
            if (bc < 3) { const int sn = ((bc + 1) & 1) * L_SET;
                *(LAS v4u*)(lds + sn + r0 * TS + ch * 16) = pa0; *(LAS v4u*)(lds + sn + (r0 + 32) * TS + ch * 16) = pa1;
                *(LAS v4u*)(lds + sn + TILE + r0 * TS + ch * 16) = pb0; *(LAS v4u*)(lds + sn + TILE + (r0 + 32) * TS + ch * 16) = pb1; }
            __syncthreads();
        }
        { const size_t go = (tokb + r0) * 1024 + h * 128 + ch * 8;
          pa0 = *(const v4u*)(KN + go); pa1 = *(const v4u*)(KN + go + 32 * 1024); pb0 = __builtin_nontemporal_load((const v4u*)(VN + go)); pb1 = __builtin_nontemporal_load((const v4u*)(VN + go + 32 * 1024));
          *(LAS v4u*)(lds + r0 * TS + ch * 16) = pa0; *(LAS v4u*)(lds + (r0 + 32) * TS + ch * 16) = pa1;
          *(LAS v4u*)(lds + TILE + r0 * TS + ch * 16) = pb0; *(LAS v4u*)(lds + TILE + (r0 + 32) * TS + ch * 16) = pb1; }
        if (wave < 4) {
            LAS float* Ml = (LAS float*)(lds + L_M + wave * TILE);
            float Tc[64];
            f32x4 mrow[16], mnxt[16];
#pragma unroll
            for (int i = 0; i < 64; ++i) {
#pragma unroll
                for (int j4 = 0; j4 < (i + 4) / 4 && i + 1 < 64; ++j4) mnxt[j4] = *(const LAS f32x4*)(Ml + (i + 1) * 68 + 4 * j4);
                f32x4 acc = {0.f, 0.f, 0.f, 0.f};
#pragma unroll
                for (int j4 = 0; j4 < (i + 3) / 4; ++j4) {
                    const f32x4 m = mrow[j4];
                    if (4 * j4 + 0 < i) acc.x += m.x * Tc[4 * j4 + 0];
                    if (4 * j4 + 1 < i) acc.y += m.y * Tc[4 * j4 + 1];
                    if (4 * j4 + 2 < i) acc.z += m.z * Tc[4 * j4 + 2];
                    if (4 * j4 + 3 < i) acc.w += m.w * Tc[4 * j4 + 3];
                }
                int l2 = lane; asm volatile("" : "+v"(l2));
                Tc[i] = ((l2 == i) ? 1.f : 0.f) - ((acc.x + acc.y) + (acc.z + acc.w));
#pragma unroll
                for (int j4 = 0; j4 < 16; ++j4) mrow[j4] = mnxt[j4];
            }
            asm volatile("" ::: "memory");
#pragma unroll
            for (int i = 0; i < 64; ++i) Ml[i * 68 + lane] = Tc[i];
        }
        __syncthreads();
#pragma unroll 1
        for (int bc = 0; bc < 4; ++bc) {
            const int cidx = base + bc; const size_t tok0 = tokb + bc * 64;
            if (bc < 3) { const size_t go = (tokb + (bc + 1) * 64 + r0) * 1024 + h * 128 + ch * 8;
                pa0 = *(const v4u*)(KN + go); pa1 = *(const v4u*)(KN + go + 32 * 1024); pb0 = __builtin_nontemporal_load((const v4u*)(VN + go)); pb1 = __builtin_nontemporal_load((const v4u*)(VN + go + 32 * 1024)); }
            const int sK = (bc & 1) * L_SET, sV = sK + TILE;
            LAS float* gcs = (LAS float*)(lds + L_GC + bc * 1024); LAS float* Tl = (LAS float*)(lds + L_M + bc * TILE);
            { const int db = wave, q = (lane & 15) >> 2, p = lane & 3;
              bf16x8 Kt[2], Vt[2];
#pragma unroll
              for (int ks = 0; ks < 2; ++ks) { const int off = (32 * ks + 8 * g + q) * TS + (16 * db + 4 * p) * 2;
                  Kt[ks] = cat8(vtr(lds + sK + off), vtr(lds + sK + off + 4 * TS));
                  Vt[ks] = cat8(vtr(lds + sV + off), vtr(lds + sV + off + 4 * TS)); }
#pragma unroll
              for (int ks = 0; ks < 2; ++ks) { const int jb0 = 32 * ks + 8 * g; const v4u kk = __builtin_bit_cast(v4u, Kt[ks]);
                  const f32x4 d0 = *(const LAS f32x4*)(gcs + 192 + jb0), d1 = *(const LAS f32x4*)(gcs + 192 + jb0 + 4); v4u o;
                  o.x = pk2(bflo(kk.x) * d0.x, bfhi(kk.x) * d0.y); o.y = pk2(bflo(kk.y) * d0.z, bfhi(kk.y) * d0.w); o.z = pk2(bflo(kk.z) * d1.x, bfhi(kk.z) * d1.y); o.w = pk2(bflo(kk.w) * d1.z, bfhi(kk.w) * d1.w);
                  *(v4u*)(KDT + (size_t)cidx * 8192 + ((db * 2 + ks) * 64 + lane) * 8) = o; }
              f32x4 su[2][2], sw[2][2];
#pragma unroll
              for (int ks = 0; ks < 2; ++ks)
#pragma unroll
                  for (int hf = 0; hf < 2; ++hf) { su[ks][hf] = *(const LAS f32x4*)(gcs + 128 + 32 * ks + 8 * g + 4 * hf); sw[ks][hf] = su[ks][hf] * *(const LAS f32x4*)(gcs + 64 + 32 * ks + 8 * g + 4 * hf); }
#pragma unroll
              for (int ib = 0; ib < 4; ++ib) {
                  f32x4 aw = {0.f, 0.f, 0.f, 0.f}, au = {0.f, 0.f, 0.f, 0.f};
#pragma unroll
                  for (int ks = 0; ks < 2; ++ks) {
                      const f32x4 t0 = *(const LAS f32x4*)(Tl + (16 * ib + c) * 68 + 32 * ks + 8 * g), t1 = *(const LAS f32x4*)(Tl + (16 * ib + c) * 68 + 32 * ks + 8 * g + 4);
                      const f32x4 w0 = t0 * sw[ks][0], w1 = t1 * sw[ks][1], u0 = t0 * su[ks][0], u1 = t1 * su[ks][1];
                      const bf16x8 Bw = pack8(w0.x, w0.y, w0.z, w0.w, w1.x, w1.y, w1.z, w1.w);
                      const bf16x8 Au = pack8(u0.x, u0.y, u0.z, u0.w, u1.x, u1.y, u1.z, u1.w);
                      aw = MFMA16(Kt[ks], Bw, aw); au = MFMA16(Au, Vt[ks], au); }
                  { v2u o; o.x = pk2(aw[0], aw[1]); o.y = pk2(aw[2], aw[3]); const int R = 4 * (ib * 4 + (db >> 1)) + ((2 * db + (g >> 1)) & 3), C = c * 8 + ((4 * g) & 7);
                    *(v2u*)(WOUT + (tok0 + R) * 1024 + h * 128 + C) = o; }
                  { v2u o; o.x = pk2(au[0], au[1]); o.y = pk2(au[2], au[3]); *(v2u*)(UT + (size_t)cidx * 8192 + ((db * 4 + ib) * 64 + lane) * 4) = o; }
              }
            }
            if (bc < 3) { const int sn = ((bc + 1) & 1) * L_SET;
                *(LAS v4u*)(lds + sn + r0 * TS + ch * 16) = pa0; *(LAS v4u*)(lds + sn + (r0 + 32) * TS + ch * 16) = pa1;
                *(LAS v4u*)(lds + sn + TILE + r0 * TS + ch * 16) = pb0; *(LAS v4u*)(lds + sn + TILE + (r0 + 32) * TS + ch * 16) = pb1; }
            __syncthreads();
        }
    }
}

__device__ __forceinline__ void p9_scan(const Args& a, LAS unsigned char* lds) {
    const int tid = threadIdx.x, lane = tid & 63, wave = __builtin_amdgcn_readfirstlane(tid >> 6), c = lane & 15, g = lane >> 4;
    unsigned char* ws = a.ws;
    const bf16* QD = (const bf16*)(ws + RGN(5)); const bf16* W = (const bf16*)(ws + RGN(6)); const bf16* KDT = (const bf16*)(ws + RGN(1));
    const bf16* ATT = (const bf16*)(ws + RGN(2)); const bf16* UT = (const bf16*)(ws + RGN(3)); bf16* O = (bf16*)(ws + RGN(0)); const float* GL = (const float*)(ws + O_GL);
    const bool first = wave < 4; const int wq = wave & 3;
    constexpr int L_ST = 0, L_VT = 4352;
    for (int it = blockIdx.x; it < 256; it += gridDim.x) {
        const int xcd = it & 7, jj = it >> 3, bh = xcd * 4 + (jj >> 3), slice = jj & 7, b = bh >> 3, h = bh & 7;
        __syncthreads();
        for (int i = tid; i < 4352 / 4; i += NTHR) ((LAS unsigned*)(lds + L_ST))[i] = 0u;
        if (tid < 128) ((LAS float*)(lds + 8192))[tid] = GL[bh * 128 + tid];
        __syncthreads();
        f32x4 Sacc = {0.f, 0.f, 0.f, 0.f};
        const bf16* Ap = (first ? W : QD) + ((size_t)b * S_ + 16 * wq + g) * 1024 + h * 128 + c * 8;
        const bf16* Up = UT + (size_t)(bh * 128) * 8192 + ((slice * 4 + wq) * 64 + lane) * 4;
        const bf16* Xp = ATT + (size_t)(bh * 128) * 4096 + ((wq * 2) * 64 + lane) * 8;
        const size_t ustep = first ? 8192 : 0, xstep = first ? 0 : 4096;
        const bf16* Kp = KDT + (size_t)(bh * 128) * 8192 + ((wave * 2) * 64 + lane) * 8;
        const bool dummy_st = first;
        bf16* Op = dummy_st ? (bf16*)(ws + RGN(2) + 32 * MiB) + (size_t)(blockIdx.x * 8 + wave) * 4096 + lane : O + ((size_t)b * S_ + 16 * wq + 4 * g) * 1024 + h * 128 + slice * 16 + c;
        const size_t ostep = dummy_st ? 0 : 65536;
        const int vtoff = first ? L_VT + c * 144 + (16 * wq + 4 * g) * 2 : L_VT + 2304 + lane * 8;
        bf16x8 Af[4][4], Xf[4][2], Kd[4][2]; v2u uu[4]; float gl[4];
#define SCAN_LOAD(slot, nn) do { \
            _Pragma("unroll") for (int ks = 0; ks < 4; ++ks) Af[slot][ks] = *(const bf16x8*)(Ap + (size_t)(nn) * 65536 + 4096 * ks); \
            _Pragma("unroll") for (int ks = 0; ks < 2; ++ks) Kd[slot][ks] = *(const bf16x8*)(Kp + (size_t)(nn) * 8192 + 512 * ks); \
            uu[slot] = *(const v2u*)(Up + (size_t)(nn) * ustep); Xf[slot][0] = *(const bf16x8*)(Xp + (size_t)(nn) * xstep); Xf[slot][1] = *(const bf16x8*)(Xp + (size_t)(nn) * xstep + 512); \
            gl[slot] = ((const LAS float*)(lds + 8192))[nn]; } while (0)
#pragma unroll
        for (int s4 = 0; s4 < 4; ++s4) { SCAN_LOAD(s4, s4); __builtin_amdgcn_sched_barrier(0); }
#pragma unroll 1
        for (int n0 = 0; n0 < 128; n0 += 4) {
#pragma unroll
            for (int s4 = 0; s4 < 4; ++s4) {
                const int n = n0 + s4;
                f32x4 acc = {0.f, 0.f, 0.f, 0.f}, acc2 = {0.f, 0.f, 0.f, 0.f};
                { const bf16x8 S0 = *(const LAS bf16x8*)(lds + L_ST + c * 272 + (8 * g) * 2), S1 = *(const LAS bf16x8*)(lds + L_ST + c * 272 + (32 + 8 * g) * 2);
                  const bf16x8 S2 = *(const LAS bf16x8*)(lds + L_ST + c * 272 + (64 + 8 * g) * 2), S3 = *(const LAS bf16x8*)(lds + L_ST + c * 272 + (96 + 8 * g) * 2);
                  acc = MFMA16(Af[s4][0], S0, acc); acc2 = MFMA16(Af[s4][1], S1, acc2); acc = MFMA16(Af[s4][2], S2, acc); acc2 = MFMA16(Af[s4][3], S3, acc2); acc = acc + acc2; }
                { v2u o; o.x = pk2(bflo(uu[s4].x) - acc[0], bfhi(uu[s4].x) - acc[1]); o.y = pk2(bflo(uu[s4].y) - acc[2], bfhi(uu[s4].y) - acc[3]);
                    *(LAS v2u*)(lds + vtoff) = o; }
                __syncthreads();
                bf16x8 Vb[2];
#pragma unroll
                for (int ks = 0; ks < 2; ++ks) Vb[ks] = *(const LAS bf16x8*)(lds + L_VT + c * 144 + (32 * ks + 8 * g) * 2);
                { acc = MFMA16(Xf[s4][0], Vb[0], acc); acc = MFMA16(Xf[s4][1], Vb[1], acc);
                    bf16* op = Op + (size_t)n * ostep; const unsigned p01 = pk2(acc[0], acc[1]), p23 = pk2(acc[2], acc[3]);
                    op[0] = (bf16)(p01 & 0xffffu); op[1024] = (bf16)(p01 >> 16); op[2048] = (bf16)(p23 & 0xffffu); op[3072] = (bf16)(p23 >> 16); }
                Sacc = Sacc * gl[s4];
                Sacc = MFMA16(Kd[s4][0], Vb[0], Sacc); Sacc = MFMA16(Kd[s4][1], Vb[1], Sacc);
                { v2u o; o.x = pk2(Sacc[0], Sacc[1]); o.y = pk2(Sacc[2], Sacc[3]); *(LAS v2u*)(lds + L_ST + c * 272 + (16 * wave + 4 * g) * 2) = o; }
                const int nl = (n + 4 < 128) ? n + 4 : n;
                SCAN_LOAD(s4, nl);
                __syncthreads();
            }
        }
#undef SCAN_LOAD
    }
}

__device__ __forceinline__ void p10_gate(const Args& a) {
    const int tid = threadIdx.x, lane = tid & 63, wave = tid >> 6;
    const int gw = blockIdx.x * NW + wave, NGW = gridDim.x * NW;
    unsigned char* ws = a.ws;
    const bf16* O = (const bf16*)(ws + RGN(0)); const bf16* Z = (const bf16*)(ws + RGN(4)); bf16* Y1 = (bf16*)(ws + RGN(1));
    const float* on = (const float*)a.in[16];
    float gn[16];
#pragma unroll
    for (int e = 0; e < 16; ++e) gn[e] = on[(16 * lane + e) & 127];
    for (int m = gw; m < T_; m += NGW) {
        const size_t off = (size_t)m * 1024 + 16 * lane;
        const v4u o0 = __builtin_nontemporal_load((const v4u*)(O + off)), o1 = __builtin_nontemporal_load((const v4u*)(O + off + 8)), z0 = __builtin_nontemporal_load((const v4u*)(Z + off)), z1 = __builtin_nontemporal_load((const v4u*)(Z + off + 8));
        float ov[16] = {bflo(o0.x), bfhi(o0.x), bflo(o0.y), bfhi(o0.y), bflo(o0.z), bfhi(o0.z), bflo(o0.w), bfhi(o0.w), bflo(o1.x), bfhi(o1.x), bflo(o1.y), bfhi(o1.y), bflo(o1.z), bfhi(o1.z), bflo(o1.w), bfhi(o1.w)};
        const float zv[16] = {bflo(z0.x), bfhi(z0.x), bflo(z0.y), bfhi(z0.y), bflo(z0.z), bfhi(z0.z), bflo(z0.w), bfhi(z0.w), bflo(z1.x), bfhi(z1.x), bflo(z1.y), bfhi(z1.y), bflo(z1.z), bfhi(z1.z), bflo(z1.w), bfhi(z1.w)};
        float ss = 0.f;
#pragma unroll
        for (int e = 0; e < 16; ++e) ss += ov[e] * ov[e];
        ss += __shfl_xor(ss, 1); ss += __shfl_xor(ss, 2); ss += __shfl_xor(ss, 4);
        const float rs = rsqrtf(ss * (1.f / 128.f) + EPS);
#pragma unroll
        for (int e = 0; e < 16; ++e) ov[e] = ov[e] * rs * gn[e] * silu(zv[e]);
        v4u r0, r1; r0.x = pk2(ov[0], ov[1]); r0.y = pk2(ov[2], ov[3]); r0.z = pk2(ov[4], ov[5]); r0.w = pk2(ov[6], ov[7]);
        r1.x = pk2(ov[8], ov[9]); r1.y = pk2(ov[10], ov[11]); r1.z = pk2(ov[12], ov[13]); r1.w = pk2(ov[14], ov[15]);
        *(v4u*)(Y1 + off) = r0; *(v4u*)(Y1 + off + 8) = r1;
    }
}

__device__ __forceinline__ void p12_final(const Args& a) {
    const int tid = threadIdx.x, lane = tid & 63, wave = tid >> 6;
    const int gw = blockIdx.x * NW + wave, NGW = gridDim.x * NW;
    const float* g = (const float*)a.in[18];
    f32x4 gv[4];
#pragma unroll
    for (int j = 0; j < 4; ++j) gv[j] = *(const f32x4*)(g + 4 * lane + 256 * j);
    const bf16* DL = (const bf16*)(a.ws + RGN(2));
    f32x4 nv[4]; v2u nd[4];
    { const int m0 = gw < T_ ? gw : 0; const f32x4* xr0 = (const f32x4*)(a.out + (size_t)m0 * D_) + lane; const v2u* dr = (const v2u*)(DL + (size_t)m0 * D_) + lane;
#pragma unroll
      for (int j = 0; j < 4; ++j) { nv[j] = __builtin_nontemporal_load(xr0 + 64 * j); nd[j] = __builtin_nontemporal_load(dr + 64 * j); } }
    for (int m = gw; m < T_; m += NGW) {
        f32x4* xw = (f32x4*)(a.out + (size_t)m * D_) + lane; f32x4 v[4]; float s = 0.f;
        { const int mn = (m + NGW < T_) ? m + NGW : m; const f32x4* xn = (const f32x4*)(a.out + (size_t)mn * D_) + lane; const v2u* dn = (const v2u*)(DL + (size_t)mn * D_) + lane;
#pragma unroll
          for (int j = 0; j < 4; ++j) { v[j].x = nv[j].x + bflo(nd[j].x); v[j].y = nv[j].y + bfhi(nd[j].x); v[j].z = nv[j].z + bflo(nd[j].y); v[j].w = nv[j].w + bfhi(nd[j].y); nv[j] = __builtin_nontemporal_load(xn + 64 * j); nd[j] = __builtin_nontemporal_load(dn + 64 * j); } }
#pragma unroll
        for (int j = 0; j < 4; ++j) s += (v[j].x * v[j].x + v[j].y * v[j].y) + (v[j].z * v[j].z + v[j].w * v[j].w);
        const float rs = rsqrtf(wave_sum(s) * (1.f / D_) + EPS);
#pragma unroll
        for (int j = 0; j < 4; ++j) __builtin_nontemporal_store(v[j] * rs * gv[j], xw + 64 * j);
    }
}

constexpr int NPH = 13;
__global__ void __launch_bounds__(NTHR, 2) fwd(Args a) {
    extern __shared__ __attribute__((aligned(16))) unsigned char smem[];
    LAS unsigned char* lds = (LAS unsigned char*)smem;
    cg::grid_group grid = cg::this_grid();
    unsigned char* ws = a.ws;
    const int G = gridDim.x, bx = blockIdx.x;
#define IN(k) (a.ph_lo <= (k) && (k) < a.ph_hi)
    volatile LAS unsigned* xst = (volatile LAS unsigned*)(lds + LDS_BYTES - 16);
    if (threadIdx.x < 4) xst[threadIdx.x] = 0u;
    __syncthreads();
    XcdBarrier xbar; xbar.bar = (unsigned*)(ws + O_BAR); xbar.x = 0; xbar.st = xst;
#define SEAM(k) do { if (IN(k) && IN((k) + 1)) xcd_barrier(xbar); } while (0)
    if (IN(0) && IN(1)) { if (blockIdx.x == 0) for (int i = threadIdx.x; i < XCD_BAR_WORDS; i += NTHR) ((unsigned*)(ws + O_BAR))[i] = 0u;
                          grid.sync(); xbar = xcd_barrier_post((unsigned*)(ws + O_BAR), xst); }
    if (IN(0)) p0_prologue(a, lds);
    SEAM(0);
    if (IN(1)) { pg8::Gemm g{(const bf16*)(ws + RGN(0)), (const bf16*)(ws + O_WIN0), T_, 2048, 1024}; pg8::StaticOrder S; S.init(T_, 2048, G, bx);
        pg8::EpiB E{(bf16*)(ws + RGN(1)), P0LD, 0, 0}; pg8::gemm_phase<pg8::EpiB, pg8::StaticOrder, true, true>(lds, g, S, E); }
    SEAM(1);
    if (IN(2)) p2_prep(a);
    SEAM(2);
    if (IN(3)) {
        { pg8::Gemm g{(const bf16*)(ws + RGN(5)), (const bf16*)(ws + O_WQKV), T_, 1792, 384}; pg8::StaticOrder S; S.init(T_, 1792, G, bx);
          pg8::EpiB E{(bf16*)(ws + O_QKV), 1792, 0, 0}; pg8::gemm_phase<pg8::EpiB, pg8::StaticOrder, true, true>(lds, g, S, E); }
        { pg8::Gemm g{(const bf16*)(ws + RGN(5) + 26 * MiB), (const bf16*)(ws + O_WPOOL), T_, 512, 512}; pg8::StaticOrder S; S.init(T_, 512, G, bx);
          pg8::EpiGate E{(bf16*)(ws + RGN(0)) + 512, 1024, (const bf16*)(ws + RGN(1)) + 1440, P0LD, (const float*)a.in[9]};
          pg8::gemm_phase<pg8::EpiGate, pg8::StaticOrder, true, true>(lds, g, S, E); }
    }
    SEAM(3);
    if (IN(4)) p4_attn(a, lds);
    SEAM(4);
    if (IN(5)) { pg8::Gemm g{(const bf16*)(ws + RGN(0)), (const bf16*)(ws + O_WOUTAB), T_, 1024, 1024}; pg8::StaticOrder S; S.init(T_, 1024, G, bx);
        pg8::EpiB E{(bf16*)(ws + RGN(1)), 1024, 0, 0}; pg8::gemm_phase<pg8::EpiB, pg8::StaticOrder, true, true>(lds, g, S, E); }
    SEAM(5);
    if (IN(6)) p6_norm_ab(a, lds);
    SEAM(6);
    if (IN(7)) { pg8::Gemm g{(const bf16*)(ws + RGN(0)), (const bf16*)(ws + O_WINC), T_, 4096, 1024}; pg8::StaticOrder S; S.init(T_, 4096, G, bx);
        pg8::EpiB E{(bf16*)(ws + RGN(1)), 1024, 1024, REG / 2}; pg8::gemm_phase<pg8::EpiB, pg8::StaticOrder, true, true>(lds, g, S, E); }
    SEAM(7);
    if (IN(8)) p8a_conv(a);
    SEAM(8);
    if (IN(9)) p8b_chunk(a, lds);
    SEAM(9);
    if (IN(10)) p9_scan(a, lds);
    SEAM(10);
    if (IN(11)) p10_gate(a);
    SEAM(11);
    if (IN(12)) { pg8::Gemm g{(const bf16*)(ws + RGN(1)), (const bf16*)(ws + O_WOUTC), T_, 1024, 1024}; pg8::StaticOrder S; S.init(T_, 1024, G, bx);
        pg8::EpiB E{(bf16*)(ws + RGN(2)), 1024, 0, 0}; pg8::gemm_phase<pg8::EpiB, pg8::StaticOrder, true, true>(lds, g, S, E); }
    SEAM(12);
    if (IN(13)) p12_final(a);
}

#ifndef MK_MULTI
#define MK_MULTI 0
#endif
extern "C" void kernel_launch(void* const* d_in, const int* in_sizes, int n_in, void* d_out, int out_size, void* d_ws, size_t ws_size, hipStream_t stream) {
    static int grid = 0;
    if (grid == 0) {
        if (n_in != 19 || out_size != T_ * D_ || ws_size < WS_NEED) { fprintf(stderr, "kernel_launch: unexpected shapes (n_in %d out %d ws %zu need %zu)\n", n_in, out_size, ws_size, (size_t)WS_NEED); grid = -1; return; }
        int dev = 0, cus = 0, per_cu = 0;
        hipGetDevice(&dev); hipDeviceGetAttribute(&cus, hipDeviceAttributeMultiprocessorCount, dev);
        if (hipFuncSetAttribute((const void*)fwd, hipFuncAttributeMaxDynamicSharedMemorySize, LDS_BYTES) != hipSuccess) { fprintf(stderr, "kernel_launch: hipFuncSetAttribute failed\n"); grid = -1; return; }
        hipOccupancyMaxActiveBlocksPerMultiprocessor(&per_cu, (const void*)fwd, NTHR, LDS_BYTES);
        (void)hipGetLastError();
        if (per_cu < 1) per_cu = 1;
        grid = cus * 1;
        if (grid > 256) grid = 256;
    }
    if (grid < 0) return;
    Args a{};
    for (int i = 0; i < 19; ++i) a.in[i] = d_in[i];
    a.out = (float*)d_out; a.ws = (unsigned char*)d_ws;
    for (int i = 0; i < 16; ++i) a.inv_freq[i] = 1.0f / powf(10000.0f, (float)i / 16.0f);
#if MK_MULTI
#ifndef PROBE_PH
#define PROBE_PH -1
#endif
#ifndef PROBE_REPS
#define PROBE_REPS 0
#endif
    for (int p = 0; p <= NPH; ++p) { const int reps = 1 + (p == PROBE_PH ? PROBE_REPS : 0);
        for (int r = 0; r < reps; ++r) { a.ph_lo = p; a.ph_hi = p + 1; a.dry = (p == 9 && r + 1 < reps) ? 1 : 0;
#ifdef PROBE_DRYMODE
            if (p == 10 && r + 1 < reps) a.dry = PROBE_DRYMODE;
#endif
            hipLaunchKernelGGL(fwd, dim3(grid), dim3(NTHR), LDS_BYTES, stream, a); } }
#else
    a.ph_lo = 0; a.ph_hi = NPH + 1;
    void* args[] = {&a};
    hipError_t e = hipLaunchCooperativeKernel((const void*)fwd, dim3(grid), dim3(NTHR), args, LDS_BYTES, stream);
    if (e != hipSuccess) fprintf(stderr, "cooperative launch failed: %s (grid %d)\n", hipGetErrorString(e), grid);
#endif
}
```

```cpp
#include <hip/hip_runtime.h>
#include <hip/hip_cooperative_groups.h>
#include <cstdio>
#include <cstdint>
#include <cmath>
namespace cg = cooperative_groups;
namespace pg8 {
#define PG8_LAS __attribute__((address_space(3)))
typedef unsigned short bf16_t;
typedef short bf16x8 __attribute__((ext_vector_type(8)));
typedef float f32x4 __attribute__((ext_vector_type(4)));
typedef unsigned u32x4 __attribute__((ext_vector_type(4)));
constexpr int BM = 256, BK = 64, HALF = 128, HTB = HALF * BK * 2  , STAGE_BYTES = 8 * HTB, NXCD = 8, WGM = 8;

__host__ __device__ __forceinline__ int lds_byte(int r, int c) { const int st = (r >> 4) * 2 + (c >> 5), rr = r & 15, cc = c & 31, ob = rr * 64 + cc * 2; return st * 1024 + (ob ^ (((ob >> 9) & 1) << 5)); }
__host__ __device__ __forceinline__ void stage_rc(int b, int& R, int& C) { const int st = b / 1024, sb = b % 1024, swz = sb ^ (((sb >> 9) & 1) << 5); R = (st >> 1) * 16 + swz / 64; C = (st & 1) * 32 + (swz % 64) / 2; }
__host__ __device__ __forceinline__ int perm32(int rho) { const int n = rho >> 4, i = rho & 15; return 8 * (i >> 2) + 4 * n + (i & 3); }

struct Unit { int pm, pn; };
struct Gemm { const bf16_t* A; const bf16_t* Bt; int M, N, K; };

struct StaticOrder {
    int nM, nN, nwg, G, c;
    __host__ __device__ void init(int M, int N, int G_, int c_) { nM = M / BM; nN = N / BM; nwg = nM * nN; G = G_; c = c_; }
    __host__ __device__ bool next(int i, Unit& u) const {
        const long L = (long)i * G + c; if (L >= nwg) return false;
        int wgid = (int)L; { const int q = nwg / NXCD, r = nwg % NXCD, xcd = wgid % NXCD, off = wgid / NXCD; wgid = (xcd < r ? xcd * (q + 1) : r * (q + 1) + (xcd - r) * q) + off; }
        const int nig = WGM * nN, gid = wgid / nig, fm = gid * WGM, gsz = (nM - fm) < WGM ? (nM - fm) : WGM;
        u.pm = fm + ((wgid % nig) % gsz); u.pn = (wgid % nig) / gsz; return true;
    }
    __device__ __forceinline__ void a_ready(const Unit&) const {}
    __device__ __forceinline__ void done(const Unit&) const {}
};

__device__ __forceinline__ unsigned cvt_pk_bf16(float lo, float hi) { unsigned r; asm volatile("v_cvt_pk_bf16_f32 %0, %1, %2" : "=v"(r) : "v"(lo), "v"(hi)); return r; }

__device__ __forceinline__ unsigned lane_xpose(unsigned v, int src4) { return (unsigned)__builtin_amdgcn_ds_bpermute(src4, (int)v); }
__device__ __forceinline__ float lane_xposef(float v, int src4) { return __builtin_bit_cast(float, __builtin_amdgcn_ds_bpermute(src4, __builtin_bit_cast(int, v))); }
struct EpiB {
    static constexpr bool PERM = true, AFTER_DRAIN = false;
    bf16_t* O; int ldc; int split_cols; size_t split_stride;
    __device__ __forceinline__ void operator()(const f32x4 (&acc)[2][2][4][2], const Unit& u, int wr, int wc, int fr, int fq) const {
        const int L = fq * 16 + fr, Lr = L >> 2, Lq = L & 3, src4 = (16 * Lq + Lr) * 4;
        const int row0 = u.pm * BM + wr * 64 + Lr; int colt = u.pn * BM; bf16_t* base = O;
        if (split_cols) { const int t = colt / split_cols; base += (size_t)t * split_stride; colt -= t * split_cols; }
        const int col0 = colt + wc * 32 + 8 * Lq;
#pragma unroll
        for (int ai = 0; ai < 2; ++ai)
#pragma unroll
            for (int m = 0; m < 4; ++m) { bf16_t* rowp = base + (size_t)(row0 + ai * HALF + m * 16) * ldc + col0;
#pragma unroll
                for (int bj = 0; bj < 2; ++bj) { const f32x4 v0 = acc[ai][bj][m][0], v1 = acc[ai][bj][m][1];
                    u32x4 w; w.x = lane_xpose(cvt_pk_bf16(v0[0], v0[1]), src4); w.y = lane_xpose(cvt_pk_bf16(v0[2], v0[3]), src4); w.z = lane_xpose(cvt_pk_bf16(v1[0], v1[1]), src4); w.w = lane_xpose(cvt_pk_bf16(v1[2], v1[3]), src4);
                    *(u32x4*)(rowp + bj * HALF) = w; } }
    }
};
struct EpiRes {
    static constexpr bool PERM = true, AFTER_DRAIN = false;
    const float* R; float* O; int ldc;
    __device__ __forceinline__ void operator()(const f32x4 (&acc)[2][2][4][2], const Unit& u, int wr, int wc, int fr, int fq) const {
        const int L = fq * 16 + fr, Lr = L >> 2, Lq = L & 3, src4 = (16 * Lq + Lr) * 4;
        const int row0 = u.pm * BM + wr * 64 + Lr; const int col0 = u.pn * BM + wc * 32 + 8 * Lq;
#pragma unroll
        for (int ai = 0; ai < 2; ++ai)
#pragma unroll
            for (int m = 0; m < 4; ++m) { const size_t ro = (size_t)(row0 + ai * HALF + m * 16) * ldc + col0;
#pragma unroll
                for (int bj = 0; bj < 2; ++bj) { const size_t o = ro + bj * HALF;
                    const f32x4 r0 = *(const f32x4*)(R + o), r1 = *(const f32x4*)(R + o + 4);
                    const f32x4 s0 = acc[ai][bj][m][0], s1 = acc[ai][bj][m][1];
                    f32x4 a0, a1;
                    a0.x = lane_xposef(s0.x, src4); a0.y = lane_xposef(s0.y, src4); a0.z = lane_xposef(s0.z, src4); a0.w = lane_xposef(s0.w, src4);
                    a1.x = lane_xposef(s1.x, src4); a1.y = lane_xposef(s1.y, src4); a1.z = lane_xposef(s1.z, src4); a1.w = lane_xposef(s1.w, src4);
                    *(f32x4*)(O + o) = r0 + a0; *(f32x4*)(O + o + 4) = r1 + a1; } }
    }
};
struct EpiGate {
    static constexpr bool PERM = true, AFTER_DRAIN = false;
    bf16_t* O; int ldc; const bf16_t* Z; int ldz; const float* PS;
    __device__ __forceinline__ void operator()(const f32x4 (&acc)[2][2][4][2], const Unit& u, int wr, int wc, int fr, int fq) const {
        const int L = fq * 16 + fr, Lr = L >> 2, Lq = L & 3, src4 = (16 * Lq + Lr) * 4;
        const int row0 = u.pm * BM + wr * 64 + Lr; const int col0 = u.pn * BM + wc * 32 + 8 * Lq;
#pragma unroll
        for (int ai = 0; ai < 2; ++ai)
#pragma unroll
            for (int m = 0; m < 4; ++m) { const size_t row = (size_t)(row0 + ai * HALF + m * 16);
#pragma unroll
                for (int bj = 0; bj < 2; ++bj) { const int col = col0 + bj * HALF;
                    const f32x4 s0 = acc[ai][bj][m][0], s1 = acc[ai][bj][m][1];
                    const float a0 = lane_xposef(s0.x, src4), a1 = lane_xposef(s0.y, src4), a2 = lane_xposef(s0.z, src4), a3 = lane_xposef(s0.w, src4);
                    const float a4 = lane_xposef(s1.x, src4), a5 = lane_xposef(s1.y, src4), a6 = lane_xposef(s1.z, src4), a7 = lane_xposef(s1.w, src4);
                    const u32x4 z = __builtin_nontemporal_load((const u32x4*)(Z + row * ldz + col)); const f32x4 p0 = *(const f32x4*)(PS + col), p1 = *(const f32x4*)(PS + col + 4);
                    const float z0 = __builtin_bit_cast(float, z.x << 16), z1 = __builtin_bit_cast(float, z.x & 0xffff0000u), z2 = __builtin_bit_cast(float, z.y << 16), z3 = __builtin_bit_cast(float, z.y & 0xffff0000u);
                    const float z4 = __builtin_bit_cast(float, z.z << 16), z5 = __builtin_bit_cast(float, z.z & 0xffff0000u), z6 = __builtin_bit_cast(float, z.w << 16), z7 = __builtin_bit_cast(float, z.w & 0xffff0000u);
#define PG8_SILU(x) ((x) * __builtin_amdgcn_rcpf(1.f + __expf(-(x))))
                    u32x4 w; w.x = cvt_pk_bf16(a0 * p0.x * PG8_SILU(z0), a1 * p0.y * PG8_SILU(z1)); w.y = cvt_pk_bf16(a2 * p0.z * PG8_SILU(z2), a3 * p0.w * PG8_SILU(z3));
                    w.z = cvt_pk_bf16(a4 * p1.x * PG8_SILU(z4), a5 * p1.y * PG8_SILU(z5)); w.w = cvt_pk_bf16(a6 * p1.z * PG8_SILU(z6), a7 * p1.w * PG8_SILU(z7));
#undef PG8_SILU
                    *(u32x4*)(O + row * ldc + col) = w; } }
    }
};
template <class Epi, class Sched, bool ALIGN_EPI = false, bool SP2 = false>
__device__ __forceinline__ void gemm_phase(PG8_LAS unsigned char* lds, const Gemm g, const Sched& S, const Epi& E) {
    const int tid = threadIdx.x, wid = __builtin_amdgcn_readfirstlane(tid >> 6), lane = tid & 63, wr = wid >> 2, wc = wid & 3, fr = lane & 15, fq = lane >> 4;
    const int K = g.K, nt = K / BK;
    unsigned voffA[2], voffB[2];
#pragma unroll
    for (int i = 0; i < 2; ++i) { int R, C; stage_rc(tid * 16 + i * 8192, R, C); const int Rb = Epi::PERM ? ((R & ~31) + perm32(R & 31)) : R;
        voffA[i] = (unsigned)(R * K + C) * 2u; voffB[i] = (unsigned)(Rb * K + C) * 2u; }
    const size_t kstep = (size_t)(BK * 2);
    const size_t hstep = (size_t)HALF * K * 2;
    const size_t tstep = 2 * hstep;
    const unsigned ldsw = (unsigned)wid * 1024u;
    const int aoff = lds_byte(wr * 64 + fr, fq * 8), boff = lds_byte(wc * 32 + fr, fq * 8);
#define PG8_SA(b, h) (((b) * 2 + (h)) * HTB)
#define PG8_SB(b, h) ((4 + (b) * 2 + (h)) * HTB)
#define PG8_STAGE(bufoff, gbase, voff) do { _Pragma("unroll") for (int _i = 0; _i < 2; ++_i) \
        __builtin_amdgcn_global_load_lds((const unsigned*)((const char*)(gbase) + (voff)[_i]), (PG8_LAS unsigned*)(lds + (bufoff) + ldsw + _i * 8192), 16, 0, 0); } while (0)
#define PG8_LDA(dst, b, h) do { _Pragma("unroll") for (int m = 0; m < 4; ++m) _Pragma("unroll") for (int k = 0; k < 2; ++k) dst[m][k] = *(const PG8_LAS bf16x8*)(lds + PG8_SA(b, h) + aoff + m * 2048 + k * 1024); } while (0)
#define PG8_LDB(dst, b, h) do { _Pragma("unroll") for (int n = 0; n < 2; ++n) _Pragma("unroll") for (int k = 0; k < 2; ++k) dst[n][k] = *(const PG8_LAS bf16x8*)(lds + PG8_SB(b, h) + boff + n * 2048 + k * 1024); } while (0)
#define PG8_MMA(ai, bj, At, Bt) do { __builtin_amdgcn_s_setprio(1); _Pragma("unroll") for (int m = 0; m < 4; ++m) _Pragma("unroll") for (int n = 0; n < 2; ++n) _Pragma("unroll") for (int k = 0; k < 2; ++k) \
        acc[ai][bj][m][n] = __builtin_amdgcn_mfma_f32_16x16x32_bf16(Bt[n][k], At[m][k], acc[ai][bj][m][n], 0, 0, 0); __builtin_amdgcn_s_setprio(0); } while (0)
#define PG8_WAIT_V(n) asm volatile("s_waitcnt vmcnt(" #n ")" ::: "memory")
#define PG8_WAIT_L(n) asm volatile("s_waitcnt lgkmcnt(" #n ")" ::: "memory")
#define PG8_BAR __builtin_amdgcn_s_barrier()
#define PG8_SCHED __builtin_amdgcn_sched_barrier(0)
    Unit cur, nxt; int ui = 0;
    if (!S.next(0, cur)) return;
    f32x4 acc[2][2][4][2];
#pragma unroll
    for (int a = 0; a < 2; ++a)
#pragma unroll
        for (int b = 0; b < 2; ++b)
#pragma unroll
            for (int m = 0; m < 4; ++m)
#pragma unroll
                for (int n = 0; n < 2; ++n) acc[a][b][m][n] = (f32x4){0.f, 0.f, 0.f, 0.f};
    bf16x8 At[4][2], B0[2][2], B1[2][2];
    const char* cA = (const char*)g.A + (size_t)cur.pm * tstep; const char* cB = (const char*)g.Bt + (size_t)cur.pn * tstep;
    S.a_ready(cur);
    if constexpr (SP2) {
        PG8_STAGE(PG8_SB(0, 0), cB, voffB); PG8_STAGE(PG8_SB(0, 1), cB + hstep, voffB); PG8_STAGE(PG8_SA(0, 0), cA, voffA); PG8_STAGE(PG8_SA(0, 1), cA + hstep, voffA);
        if (wr == 1) PG8_BAR;
        PG8_WAIT_V(2); PG8_BAR;
        PG8_STAGE(PG8_SB(1, 0), cB + kstep, voffB); PG8_STAGE(PG8_SA(1, 0), cA + kstep, voffA); PG8_STAGE(PG8_SB(1, 1), cB + hstep + kstep, voffB);
        PG8_WAIT_V(6); PG8_BAR;
    } else {
        PG8_STAGE(PG8_SB(0, 0), cB, voffB); PG8_STAGE(PG8_SA(0, 0), cA, voffA); PG8_STAGE(PG8_SB(0, 1), cB + hstep, voffB); PG8_STAGE(PG8_SA(0, 1), cA + hstep, voffA);
        if (wr == 1) PG8_BAR;
        PG8_WAIT_V(4); PG8_BAR;
        PG8_STAGE(PG8_SB(1, 0), cB + kstep, voffB); PG8_STAGE(PG8_SA(1, 0), cA + kstep, voffA); PG8_STAGE(PG8_SB(1, 1), cB + hstep + kstep, voffB);
        PG8_WAIT_V(6); PG8_BAR;
    }
    for (;;) {
        const bool has_next = S.next(ui + 1, nxt);
        const char* nA = has_next ? (const char*)g.A + (size_t)nxt.pm * tstep : cA; const char* nB = has_next ? (const char*)g.Bt + (size_t)nxt.pn * tstep : cB;
        for (int t = 0; t < nt; t += 2) {
            const bool last = (t == nt - 2);
            const char* a1 = cA + (size_t)(t + 1) * kstep;
            const char* a2 = last ? nA : cA + (size_t)(t + 2) * kstep; const char* b2 = last ? nB : cB + (size_t)(t + 2) * kstep;
            const char* a3 = a2 + kstep; const char* b3 = b2 + kstep;
            if (last && has_next) S.a_ready(nxt);
            if constexpr (SP2) {
            PG8_LDB(B0, 0, 0); PG8_LDB(B1, 0, 1); PG8_SCHED; PG8_LDA(At, 0, 0); PG8_STAGE(PG8_SA(1, 1), a1 + hstep, voffA);
            PG8_WAIT_V(8); PG8_WAIT_L(0); PG8_BAR; PG8_MMA(0, 0, At, B0); PG8_MMA(0, 1, At, B1); PG8_BAR; PG8_SCHED;
            PG8_LDA(At, 0, 1); PG8_STAGE(PG8_SB(0, 0), b2, voffB); PG8_STAGE(PG8_SB(0, 1), b2 + hstep, voffB); PG8_STAGE(PG8_SA(0, 0), a2, voffA);
            PG8_WAIT_V(8); PG8_WAIT_L(0); PG8_BAR; PG8_MMA(1, 0, At, B0); PG8_MMA(1, 1, At, B1); PG8_BAR; PG8_SCHED;
            PG8_LDB(B0, 1, 0); PG8_LDB(B1, 1, 1); PG8_SCHED; PG8_LDA(At, 1, 0); PG8_STAGE(PG8_SA(0, 1), a2 + hstep, voffA);
            PG8_WAIT_V(8); PG8_WAIT_L(0); PG8_BAR; PG8_MMA(0, 0, At, B0); PG8_MMA(0, 1, At, B1); PG8_BAR; PG8_SCHED;
            PG8_LDA(At, 1, 1); PG8_STAGE(PG8_SB(1, 0), b3, voffB); PG8_STAGE(PG8_SB(1, 1), b3 + hstep, voffB); PG8_STAGE(PG8_SA(1, 0), a3, voffA);
            PG8_WAIT_V(8); PG8_WAIT_L(0); PG8_BAR; PG8_MMA(1, 0, At, B0); PG8_MMA(1, 1, At, B1); PG8_BAR; PG8_SCHED;
            } else {
            PG8_LDB(B0, 0, 0); PG8_SCHED; PG8_LDA(At, 0, 0); PG8_STAGE(PG8_SA(1, 1), a1 + hstep, voffA);
            PG8_WAIT_L(8); PG8_BAR; PG8_WAIT_L(0); PG8_MMA(0, 0, At, B0); PG8_BAR; PG8_SCHED;
            PG8_LDB(B1, 0, 1); PG8_STAGE(PG8_SB(0, 0), b2, voffB);
            PG8_BAR; PG8_WAIT_L(0); PG8_MMA(0, 1, At, B1); PG8_BAR;
            PG8_LDA(At, 0, 1); PG8_STAGE(PG8_SA(0, 0), a2, voffA);
            PG8_BAR; PG8_WAIT_L(0); PG8_MMA(1, 0, At, B0); PG8_BAR; PG8_SCHED;
            PG8_STAGE(PG8_SB(0, 1), b2 + hstep, voffB);
            PG8_WAIT_V(6); PG8_BAR; PG8_MMA(1, 1, At, B1); PG8_BAR;
            PG8_LDB(B0, 1, 0); PG8_SCHED; PG8_LDA(At, 1, 0); PG8_STAGE(PG8_SA(0, 1), a2 + hstep, voffA);
            PG8_WAIT_L(8); PG8_BAR; PG8_WAIT_L(0); PG8_MMA(0, 0, At, B0); PG8_BAR; PG8_SCHED;
            PG8_LDB(B1, 1, 1); PG8_STAGE(PG8_SB(1, 0), b3, voffB);
            PG8_BAR; PG8_WAIT_L(0); PG8_MMA(0, 1, At, B1); PG8_BAR;
            PG8_LDA(At, 1, 1); PG8_STAGE(PG8_SA(1, 0), a3, voffA);
            PG8_BAR; PG8_WAIT_L(0); PG8_MMA(1, 0, At, B0); PG8_BAR; PG8_SCHED;
            PG8_STAGE(PG8_SB(1, 1), b3 + hstep, voffB);
            PG8_WAIT_V(6); PG8_BAR; PG8_MMA(1, 1, At, B1); PG8_BAR;
            }
        }
        if constexpr (ALIGN_EPI) { if (wr == 0) PG8_BAR; }
        if constexpr (!Epi::AFTER_DRAIN) { E(acc, cur, wr, wc, fr, fq); S.done(cur); }
        if (!has_next) break;
#pragma unroll
        for (int a = 0; a < 2; ++a)
#pragma unroll
            for (int b = 0; b < 2; ++b)
#pragma unroll
                for (int m = 0; m < 4; ++m)
#pragma unroll
                    for (int n = 0; n < 2; ++n) acc[a][b][m][n] = (f32x4){0.f, 0.f, 0.f, 0.f};
        cur = nxt; cA = nA; cB = nB; ++ui;
        if constexpr (ALIGN_EPI) { if (wr == 1) PG8_BAR; }
    }
    PG8_WAIT_V(0);
    if constexpr (!ALIGN_EPI) { if (wr == 0) PG8_BAR; }
    PG8_BAR;
    if constexpr (Epi::AFTER_DRAIN) { E.fused(acc, cur, wr, wc, fr, fq, lds, wid, lane); S.done(cur); }
#undef PG8_SA
#undef PG8_SB
#undef PG8_STAGE
#undef PG8_LDA
#undef PG8_LDB
#undef PG8_MMA
#undef PG8_WAIT_V
#undef PG8_WAIT_L
#undef PG8_BAR
#undef PG8_SCHED
}
}

#define LAS __attribute__((address_space(3)))
typedef unsigned short bf16;
typedef unsigned v4u __attribute__((ext_vector_type(4)));
typedef unsigned v2u __attribute__((ext_vector_type(2)));
typedef float f32x4 __attribute__((ext_vector_type(4)));
typedef float f32x16 __attribute__((ext_vector_type(16)));
typedef short bf16x8 __attribute__((ext_vector_type(8)));
typedef short s16x4 __attribute__((ext_vector_type(4)));
#define LDS_WAIT() asm volatile("s_waitcnt lgkmcnt(0)" ::: "memory")

constexpr int T_ = 32768, S_ = 8192, D_ = 1024, NW = 8, NTHR = 512;
constexpr size_t MiB = 1u << 20, REG = 64 * MiB;
constexpr size_t RGN(int i) { return (size_t)i * REG; }
constexpr size_t MISC = 7 * REG;
constexpr size_t O_WIN0 = MISC + 0 * MiB, O_WQKV = MISC + 4 * MiB, O_WPOOL = MISC + 6 * MiB, O_WOUTAB = MISC + 7 * MiB, O_WINC = MISC + 9 * MiB, O_WOUTC = MISC + 17 * MiB,
                 O_ROPE = MISC + 19 * MiB, O_G = MISC + 23 * MiB, O_BETA = MISC + 24 * MiB, O_GL = MISC + 25 * MiB, O_BAR = MISC + 26 * MiB, WS_NEED = MISC + 27 * MiB;
constexpr int LDS_BYTES = 147456;
constexpr int P0LD = 2176;
constexpr size_t O_QKV = 3 * REG + 16 * MiB;
constexpr float EPS = 1e-6f;

__device__ __forceinline__ float bflo(unsigned u) { return __builtin_bit_cast(float, u << 16); }
__device__ __forceinline__ float bfhi(unsigned u) { return __builtin_bit_cast(float, u & 0xffff0000u); }
__device__ __forceinline__ float bf1(bf16 b) { return __builtin_bit_cast(float, (unsigned)b << 16); }
__device__ __forceinline__ unsigned f2bf(float f) { unsigned u = __builtin_bit_cast(unsigned, f); return (u + 0x7fffu + ((u >> 16) & 1u)) >> 16; }
typedef __bf16 hwbf16x2 __attribute__((ext_vector_type(2)));
typedef float f32x2v __attribute__((ext_vector_type(2)));
__device__ __forceinline__ unsigned pk2(float lo, float hi) { const f32x2v v = {lo, hi}; return __builtin_bit_cast(unsigned, __builtin_convertvector(v, hwbf16x2)); }
__device__ __forceinline__ float row16_sum(float v) {
    v += __builtin_bit_cast(float, __builtin_amdgcn_update_dpp(0, __builtin_bit_cast(int, v), 0x128, 0xf, 0xf, false));
    v += __builtin_bit_cast(float, __builtin_amdgcn_update_dpp(0, __builtin_bit_cast(int, v), 0x124, 0xf, 0xf, false));
    v += __builtin_bit_cast(float, __builtin_amdgcn_update_dpp(0, __builtin_bit_cast(int, v), 0x122, 0xf, 0xf, false));
    v += __builtin_bit_cast(float, __builtin_amdgcn_update_dpp(0, __builtin_bit_cast(int, v), 0x121, 0xf, 0xf, false));
    return v;
}
__device__ __forceinline__ float wave_sum(float v) { v = row16_sum(v); v += __shfl_xor(v, 16); v += __shfl_xor(v, 32); return v; }
__device__ __forceinline__ float silu(float z) { return z * __builtin_amdgcn_rcpf(1.f + __expf(-z)); }


struct Args { const void* in[19]; float* out; unsigned char* ws; float inv_freq[16]; int ph_lo, ph_hi, dry, pad; };

__device__ __forceinline__ void transpose_item(const float* W, int ldw, bf16* WT, int ldt, int k0, int n0, int trow0, int tcol0, LAS float* scr, int lane) {
#pragma unroll 8
    for (int i = 0; i < 32; ++i) { const int kk = 2 * i + (lane >> 5); scr[kk * 33 + (lane & 31)] = __builtin_nontemporal_load(W + (size_t)(k0 + kk) * ldw + n0 + (lane & 31)); }
    LDS_WAIT();
    const int c = lane & 7;
#pragma unroll
    for (int j = 0; j < 4; ++j) { const int n = (lane >> 3) + 8 * j; const LAS float* s = scr + (8 * c) * 33 + n;
        v4u o; o.x = pk2(s[0 * 33], s[1 * 33]); o.y = pk2(s[2 * 33], s[3 * 33]); o.z = pk2(s[4 * 33], s[5 * 33]); o.w = pk2(s[6 * 33], s[7 * 33]);
        *(v4u*)(WT + (size_t)(trow0 + n) * ldt + tcol0 + 8 * c) = o; }
    LDS_WAIT();
}
__device__ __forceinline__ void transpose_job(const float* W, int ldw, int Nuse, bf16* WT, int ldt, int n_off, int k_off, int item, LAS float* scr, int lane) {
    const int nblk = Nuse / 32, kb = item / nblk, nb = item % nblk;
    transpose_item(W, ldw, WT, ldt, 64 * kb, 32 * nb, n_off + 32 * nb, k_off + 64 * kb, scr, lane);
}

__device__ __forceinline__ void p0_prologue(const Args& a, LAS unsigned char* lds) {
    const int tid = threadIdx.x, lane = tid & 63, wave = tid >> 6;
    const int gw = blockIdx.x * NW + wave, NGW = gridDim.x * NW;
    unsigned char* ws = a.ws;
    LAS float* scr = (LAS float*)(lds + wave * 16384);
    bf16* WIN0 = (bf16*)(ws + O_WIN0); bf16* WQKV = (bf16*)(ws + O_WQKV); bf16* WPOOL = (bf16*)(ws + O_WPOOL); bf16* WOUTAB = (bf16*)(ws + O_WOUTAB);
    bf16* WINC = (bf16*)(ws + O_WINC); bf16* WOUTC = (bf16*)(ws + O_WOUTC);
    constexpr int I0 = 16 * 61, I1 = 4 * 24, I2 = 2 * 32, I3 = 4 * 8, I4 = 16 * 32, I5 = 16 * 128, I6 = 16 * 32, NIT = I0 + I1 + I2 + I3 + I4 + I5 + I6;
    for (int it = gw; it < NIT; it += NGW) {
        int r = it;
        if (r < I0) { transpose_job((const float*)a.in[3], 1952, 1952, WIN0, 1024, 0, 0, r, scr, lane); continue; } r -= I0;
        if (r < I1) { transpose_job((const float*)a.in[5], 768, 768, WQKV, 384, 0, 0, r, scr, lane); continue; } r -= I1;
        if (r < I2) { transpose_job((const float*)a.in[7], 1024, 1024, WQKV, 384, 768, 256, r, scr, lane); continue; } r -= I2;
        if (r < I3) { const int g = r >> 3; transpose_job((const float*)a.in[8] + (size_t)g * 128 * 128, 128, 128, WPOOL, 512, g * 128, g * 128, r & 7, scr, lane); continue; } r -= I3;
        if (r < I4) { transpose_job((const float*)a.in[10], 1024, 1024, WOUTAB, 1024, 0, 0, r, scr, lane); continue; } r -= I4;
        if (r < I5) { transpose_job((const float*)a.in[12], 4112, 4096, WINC, 1024, 0, 0, r, scr, lane); continue; } r -= I5;
        transpose_job((const float*)a.in[17], 1024, 1024, WOUTC, 1024, 0, 0, r, scr, lane);
    }
    const int gt = blockIdx.x * NTHR + tid, NGT = gridDim.x * NTHR;
    const v4u z4 = {0u, 0u, 0u, 0u};
    for (int i = gt; i < 96 * 128; i += NGT) *(v4u*)(WIN0 + (size_t)1952 * 1024 + (size_t)i * 8) = z4;
    for (int i = gt; i < 1792 * 48; i += NGT) { const int row = i / 48, c8 = (i % 48) * 8; const bool isq = row < 768; const bool zero = isq ? (c8 >= 256) : (c8 < 256); if (zero) *(v4u*)(WQKV + (size_t)row * 384 + c8) = z4; }
    for (int i = gt; i < 512 * 64; i += NGT) { const int row = i / 64, c8 = (i % 64) * 8; if ((row >> 7) != (c8 >> 7)) *(v4u*)(WPOOL + (size_t)row * 512 + c8) = z4; }
    { float2* rope = (float2*)(ws + O_ROPE); const int* pos = (const int*)a.in[1];
      for (int i = gt; i < T_ * 16; i += NGT) { const int t = i >> 4, f = i & 15; const float ang = (float)pos[t] * a.inv_freq[f];
          const float C_HI = 0.15915494f, C_LO = 3.0908620e-9f;
          const float rev = ang * C_HI; const float err = fmaf(ang, C_HI, -rev) + ang * C_LO; const float fr = (rev - rintf(rev)) + err;
          rope[i] = make_float2(__builtin_amdgcn_cosf(fr), __builtin_amdgcn_sinf(fr)); } }
    { const float* x = (const float*)a.in[0]; const float* g = (const float*)a.in[2]; bf16* XN = (bf16*)(ws + RGN(0));
      f32x4 gv[4];
#pragma unroll
      for (int j = 0; j < 4; ++j) gv[j] = *(const f32x4*)(g + 4 * lane + 256 * j);
      f32x4 nv[4];
      { const f32x4* xr = (const f32x4*)(x + (size_t)(gw < T_ ? gw : 0) * D_) + lane;
#pragma unroll
        for (int j = 0; j < 4; ++j) nv[j] = __builtin_nontemporal_load(xr + 64 * j); }
      for (int m = gw; m < T_; m += NGW) {
          f32x4 v[4]; float s = 0.f;
          { const int mn = (m + NGW < T_) ? m + NGW : m; const f32x4* xn = (const f32x4*)(x + (size_t)mn * D_) + lane;
#pragma unroll
            for (int j = 0; j < 4; ++j) { v[j] = nv[j]; nv[j] = __builtin_nontemporal_load(xn + 64 * j); } }
#pragma unroll
          for (int j = 0; j < 4; ++j) s += (v[j].x * v[j].x + v[j].y * v[j].y) + (v[j].z * v[j].z + v[j].w * v[j].w);
          const float rs = rsqrtf(wave_sum(s) * (1.f / D_) + EPS);
          v2u* o8 = (v2u*)(XN + (size_t)m * D_) + lane;
#pragma unroll
          for (int j = 0; j < 4; ++j) { v2u o; o.x = pk2(v[j].x * rs * gv[j].x, v[j].y * rs * gv[j].y); o.y = pk2(v[j].z * rs * gv[j].z, v[j].w * rs * gv[j].w); o8[64 * j] = o; }
      } }
}

__device__ __forceinline__ void p2_prep(const Args& a) {
    const int tid = threadIdx.x, lane = tid & 63, wave = tid >> 6;
    const int gw = blockIdx.x * NW + wave, NGW = gridDim.x * NW;
    unsigned char* ws = a.ws;
    const bf16* proj0 = (const bf16*)(ws + RGN(1));
    bf16* A2 = (bf16*)(ws + RGN(5)); bf16* KR = (bf16*)(ws + RGN(5) + 24 * MiB); bf16* DP = (bf16*)(ws + RGN(5) + 26 * MiB);
    const float2* rope = (const float2*)(ws + O_ROPE);
    const f32x4 qg = *(const f32x4*)((const float*)a.in[4] + 4 * lane);
    const float2 kg = *(const float2*)((const float*)a.in[6] + 2 * lane);
    for (int t = gw; t < T_; t += NGW) {
        const bf16* pr = proj0 + (size_t)t * P0LD;
        { const v2u q = *(const v2u*)(pr + 4 * lane); const float q0 = bflo(q.x), q1 = bfhi(q.x), q2 = bflo(q.y), q3 = bfhi(q.y);
          const float rs = rsqrtf(wave_sum((q0 * q0 + q1 * q1) + (q2 * q2 + q3 * q3)) * (1.f / 256.f) + EPS);
          v2u o; o.x = pk2(q0 * rs * qg.x, q1 * rs * qg.y); o.y = pk2(q2 * rs * qg.z, q3 * rs * qg.w); *(v2u*)(A2 + (size_t)t * 384 + 4 * lane) = o; }
        { const unsigned k = *(const unsigned*)(pr + 256 + 2 * lane); const float k0 = bflo(k), k1 = bfhi(k);
          const float rs = rsqrtf(wave_sum(k0 * k0 + k1 * k1) * (1.f / 128.f) + EPS);
          *(unsigned*)(A2 + (size_t)t * 384 + 256 + 2 * lane) = pk2(k0 * rs * kg.x, k1 * rs * kg.y); }
        if (lane < 16) { const float x1 = bf1(pr[384 + lane]), x2 = bf1(pr[400 + lane]); const float2 cs = rope[(size_t)t * 16 + lane];
          *(unsigned*)(KR + (size_t)t * 32 + 2 * lane) = pk2(x1 * cs.x - x2 * cs.y, x2 * cs.x + x1 * cs.y); }
        { const int g = lane >> 4, w = 2 << g, ts = t & (S_ - 1), cnt = min(ts + 1, w);
          float acc[8];
#pragma unroll
          for (int e = 0; e < 8; ++e) acc[e] = 0.f;
          v4u wv[16];
#pragma unroll
          for (int j = 0; j < 16; ++j) { const int jj = (j < cnt) ? j : 0; wv[j] = *(const v4u*)(pr - (size_t)jj * P0LD + 416 + 8 * lane); }
          float x0[8];
#pragma unroll
          for (int j = 0; j < 16; ++j) { const v4u v = wv[j]; const float mk = (j < cnt) ? 1.f : 0.f;
              const float f[8] = {bflo(v.x), bfhi(v.x), bflo(v.y), bfhi(v.y), bflo(v.z), bfhi(v.z), bflo(v.w), bfhi(v.w)};
#pragma unroll
              for (int e = 0; e < 8; ++e) { acc[e] = fmaf(f[e], mk, acc[e]); if (j == 0) x0[e] = f[e]; }
          }
          const float ic = 1.f / (float)cnt; v4u o;
          o.x = pk2(acc[0] * ic - x0[0], acc[1] * ic - x0[1]); o.y = pk2(acc[2] * ic - x0[2], acc[3] * ic - x0[3]);
          o.z = pk2(acc[4] * ic - x0[4], acc[5] * ic - x0[5]); o.w = pk2(acc[6] * ic - x0[6], acc[7] * ic - x0[7]);
          *(v4u*)(DP + (size_t)t * 512 + 8 * lane) = o; }
    }
}

constexpr int KROW = 208, KBYTES = 64 * KROW, VBYTES = 8192;
typedef short v4i16_t __attribute__((ext_vector_type(4)));
__device__ __forceinline__ s16x4 vtr(const LAS unsigned char* p) { return __builtin_bit_cast(s16x4, __builtin_amdgcn_ds_read_tr16_b64_v4i16((LAS v4i16_t*)p)); }
__device__ __forceinline__ bf16x8 cat8(s16x4 lo, s16x4 hi) { bf16x8 r; r[0] = lo[0]; r[1] = lo[1]; r[2] = lo[2]; r[3] = lo[3]; r[4] = hi[0]; r[5] = hi[1]; r[6] = hi[2]; r[7] = hi[3]; return r; }
__device__ __forceinline__ bf16x8 pack8(float a0, float a1, float a2, float a3, float a4, float a5, float a6, float a7) {
    v4u u; u.x = pk2(a0, a1); u.y = pk2(a2, a3); u.z = pk2(a4, a5); u.w = pk2(a6, a7); return __builtin_bit_cast(bf16x8, u); }

__device__ __forceinline__ void attn_unit(LAS unsigned char* lds, int b, int h, int qb, const bf16* qkv, const bf16* KR, const float2* rope, const bf16* proj0, bf16* Y) {
    int tid = threadIdx.x; asm volatile("" : "+v"(tid));
    const int lane = tid & 63, wave = __builtin_amdgcn_readfirstlane(tid >> 6), r = lane & 31, hh = lane >> 5;
    const int q0 = qb * 256, myq = q0 + 32 * wave + r;
    const size_t tq = (size_t)b * S_ + myq;
    const float CS = 0.10206207261596577f * 1.4426950408889634f;
    bf16x8 Qf[6];
    { const bf16* qp = qkv + tq * 1792 + h * 96;
#pragma unroll
      for (int s = 0; s < 4; ++s) Qf[s] = __builtin_nontemporal_load((const bf16x8*)(qp + 16 * s + 8 * hh));
#pragma unroll
      for (int s2 = 0; s2 < 2; ++s2) { const int i0 = 8 * s2 + 4 * hh;
          const v2u xa = *(const v2u*)(qp + 64 + i0), xb = *(const v2u*)(qp + 80 + i0);
          const f32x4 c0 = *(const f32x4*)(rope + tq * 16 + i0), c1 = *(const f32x4*)(rope + tq * 16 + i0 + 2);
          const float a0 = bflo(xa.x), a1 = bfhi(xa.x), a2 = bflo(xa.y), a3 = bfhi(xa.y), b0 = bflo(xb.x), b1 = bfhi(xb.x), b2 = bflo(xb.y), b3 = bfhi(xb.y);
          Qf[4 + s2] = pack8(a0 * c0.x - b0 * c0.y, b0 * c0.x + a0 * c0.y, a1 * c0.z - b1 * c0.w, b1 * c0.z + a1 * c0.w,
                             a2 * c1.x - b2 * c1.y, b2 * c1.x + a2 * c1.y, a3 * c1.z - b3 * c1.w, b3 * c1.z + a3 * c1.w); } }
    const int skey = tid >> 3, sch = tid & 7, rkey = tid >> 2, rch = tid & 3;
    const bf16* kvbase = qkv + ((size_t)b * S_) * 1792 + 768 + h * 128;
    const bf16* krbase = KR + ((size_t)b * S_) * 32;
    constexpr int KB2 = 128 * KROW, VB2 = 2 * VBYTES, VOFF = 2 * KB2;
    const int NT = 2 * (qb + 1);
    const int qhi = q0 + 32 * wave + 31, qlo = q0 + 32 * wave;
    v4u gk0, gk1, gr, gv0, gv1;
#define ATT_LDK(T_) do { const size_t kk_ = (size_t)(T_) * 128; \
        gk0 = *(const v4u*)(kvbase + (kk_ + skey) * 1792 + sch * 8); gk1 = *(const v4u*)(kvbase + (kk_ + 64 + skey) * 1792 + sch * 8); \
        gr = *(const v4u*)(krbase + (kk_ + rkey) * 32 + rch * 8); } while (0)
#define ATT_LDV(T_) do { const size_t kk_ = (size_t)(T_) * 128; \
        gv0 = *(const v4u*)(kvbase + (kk_ + skey) * 1792 + 64 + sch * 8); gv1 = *(const v4u*)(kvbase + (kk_ + 64 + skey) * 1792 + 64 + sch * 8); } while (0)
#define ATT_LD(T_) do { ATT_LDK(T_); ATT_LDV(T_); } while (0)
#define ATT_STK(buf) do { LAS unsigned char* Kn_ = lds + (buf) * KB2; \
        *(LAS v4u*)(Kn_ + skey * KROW + sch * 16) = gk0; *(LAS v4u*)(Kn_ + (64 + skey) * KROW + sch * 16) = gk1; *(LAS v4u*)(Kn_ + rkey * KROW + 128 + rch * 16) = gr; } while (0)
#define ATT_STV(buf) do { LAS unsigned char* Vn_ = lds + VOFF + (buf) * VB2; \
        *(LAS v4u*)(Vn_ + (sch >> 2) * 4096 + skey * 64 + (sch & 3) * 16) = gv0; *(LAS v4u*)(Vn_ + VBYTES + (sch >> 2) * 4096 + skey * 64 + (sch & 3) * 16) = gv1; } while (0)
#define ATT_ST(buf) do { ATT_STK(buf); ATT_STV(buf); } while (0)
#define ATT_QK(dst0, dst1, Kb_) do { \
        _Pragma("unroll") for (int i_ = 0; i_ < 16; ++i_) { dst0[i_] = 0.f; dst1[i_] = 0.f; } \
        _Pragma("unroll") for (int s_ = 0; s_ < 6; ++s_) { \
            const bf16x8 ka_ = *(const LAS bf16x8*)((Kb_) + r * KROW + (16 * s_ + 8 * hh) * 2); const bf16x8 kb_ = *(const LAS bf16x8*)((Kb_) + (32 + r) * KROW + (16 * s_ + 8 * hh) * 2); \
            dst0 = __builtin_amdgcn_mfma_f32_32x32x16_bf16(ka_, Qf[s_], dst0, 0, 0, 0); dst1 = __builtin_amdgcn_mfma_f32_32x32x16_bf16(kb_, Qf[s_], dst1, 0, 0, 0); } } while (0)
#define ATT_SMPV(s0, s1, kbase_, Vb_, GEN, FIRST) do { \
        if (GEN) { \
            if ((kbase_) + 63 > qlo) { \
                _Pragma("unroll") for (int i = 0; i < 16; ++i) { const int key = (kbase_) + 8 * (i >> 2) + 4 * hh + (i & 3); \
                    if (key > myq) s0[i] = -INFINITY; if (key + 32 > myq) s1[i] = -INFINITY; } } \
            if (FIRST) { float mx = fmaxf(s0[0], s1[0]); \
                _Pragma("unroll") for (int i = 1; i < 16; ++i) mx = fmaxf(mx, fmaxf(s0[i], s1[i])); \
                m_run = fmaxf(mx, __shfl_xor(mx, 32)); } \
        } \
        const float nm = -m_run * CS; float ps = 0.f; \
        _Pragma("unroll") for (int i = 0; i < 16; ++i) { s0[i] = __builtin_amdgcn_exp2f(fmaf(s0[i], CS, nm)); s1[i] = __builtin_amdgcn_exp2f(fmaf(s1[i], CS, nm)); ps += s0[i] + s1[i]; } \
        l_run += ps; \
        const bf16x8 P00 = pack8(s0[0], s0[1], s0[2], s0[3], s0[4], s0[5], s0[6], s0[7]); \
        const bf16x8 P01 = pack8(s0[8], s0[9], s0[10], s0[11], s0[12], s0[13], s0[14], s0[15]); \
        const bf16x8 P10 = pack8(s1[0], s1[1], s1[2], s1[3], s1[4], s1[5], s1[6], s1[7]); \
        const bf16x8 P11 = pack8(s1[8], s1[9], s1[10], s1[11], s1[12], s1[13], s1[14], s1[15]); \
        _Pragma("unroll") for (int ks = 0; ks < 4; ++ks) { \
            const bf16x8 P = ks == 0 ? P00 : ks == 1 ? P01 : ks == 2 ? P10 : P11; \
            const LAS unsigned char* vp = (Vb_) + (16 * ks) * 64 + troff; \
            const bf16x8 va0 = cat8(vtr(vp), vtr(vp + 8 * 64)); \
            const bf16x8 va1 = cat8(vtr(vp + 4096), vtr(vp + 4096 + 8 * 64)); \
            o0 = __builtin_amdgcn_mfma_f32_32x32x16_bf16(va0, P, o0, 0, 0, 0); \
            o1 = __builtin_amdgcn_mfma_f32_32x32x16_bf16(va1, P, o1, 0, 0, 0); } } while (0)
#define ATT_ITER(GEN) do { \
        const int kb0 = T * 128; \
        const int Tn = T + 1 < NT ? T + 1 : T; ATT_LDK(Tn); \
        const LAS unsigned char* Kb = lds + (T & 1) * KB2; const LAS unsigned char* Vb = lds + VOFF + (T & 1) * VB2; \
        const bool actA = !(GEN) || (kb0 <= qhi), actB = !(GEN) || (kb0 + 64 <= qhi); \
        if (actA) ATT_QK(a0, a1, Kb); \
        if (actB) ATT_QK(b0, b1, Kb + 64 * KROW); \
        ATT_STK((T + 1) & 1); ATT_LDV(Tn); \
        if (actA) ATT_SMPV(a0, a1, kb0, Vb, GEN, T == 0); \
        if (actB) ATT_SMPV(b0, b1, kb0 + 64, Vb + VBYTES, GEN, false); \
        ATT_STV((T + 1) & 1); \
        __syncthreads(); } while (0)
    f32x16 o0, o1, a0, a1, b0, b1; float m_run = -INFINITY, l_run = 0.f;
#pragma unroll
    for (int i = 0; i < 16; ++i) { o0[i] = 0.f; o1[i] = 0.f; }
    const int g4 = lane >> 4, tq_ = (lane & 15) >> 2, tp = lane & 3;
    const int troff = (4 * hh + tq_) * 64 + (16 * (g4 & 1) + 4 * tp) * 2;
    ATT_LD(0); ATT_ST(0);
    __syncthreads();
    int T = 0;
    ATT_ITER(true);
    for (T = 1; T < 2 * qb; ++T) ATT_ITER(false);
    for (; T < NT; ++T) ATT_ITER(true);
#undef ATT_LD
#undef ATT_LDK
#undef ATT_LDV
#undef ATT_ST
#undef ATT_STK
#undef ATT_STV
#undef ATT_QK
#undef ATT_SMPV
#undef ATT_ITER
    const float lt = l_run + __shfl_xor(l_run, 32), inv = 1.f / lt;
    const bf16* zp = proj0 + tq * P0LD + 928 + h * 64; bf16* yp = Y + tq * 1024 + h * 64;
#pragma unroll
    for (int c = 0; c < 2; ++c)
#pragma unroll
        for (int gq = 0; gq < 4; ++gq) { const int dv = 32 * c + 8 * gq + 4 * hh;
            const v2u z = __builtin_nontemporal_load((const v2u*)(zp + dv));
            const float v0 = (c ? o1[4 * gq + 0] : o0[4 * gq + 0]) * inv, v1 = (c ? o1[4 * gq + 1] : o0[4 * gq + 1]) * inv, v2 = (c ? o1[4 * gq + 2] : o0[4 * gq + 2]) * inv, v3 = (c ? o1[4 * gq + 3] : o0[4 * gq + 3]) * inv;
            v2u o; o.x = pk2(v0 * silu(bflo(z.x)), v1 * silu(bfhi(z.x))); o.y = pk2(v2 * silu(bflo(z.y)), v3 * silu(bfhi(z.y)));
            *(v2u*)(yp + dv) = o; }
}

__device__ __forceinline__ void p4_attn(const Args& a, LAS unsigned char* lds) {
    unsigned char* ws = a.ws;
    const bf16* proj0 = (const bf16*)(ws + RGN(1)); const bf16* qkv = (const bf16*)(ws + O_QKV); const bf16* KR = (const bf16*)(ws + RGN(5) + 24 * MiB);
    const bf16* YB = (const bf16*)(ws + RGN(6)); bf16* Y = (bf16*)(ws + RGN(0)); const float2* rope = (const float2*)(ws + O_ROPE);
    for (int it = blockIdx.x; it < 512; it += gridDim.x) {
        const int xcd = it & 7, j = it >> 3, bh = xcd * 4 + (j & 3), pr = j >> 2, b = bh >> 3, h = bh & 7;
#pragma unroll 1
        for (int u = 0; u < 2; ++u) attn_unit(lds, b, h, u ? 31 - pr : pr, qkv, KR, rope, proj0, Y);
    }
}

#define XB_TMO      128
#define XB_XCNT(j)  (256  + 64 * (j))
#define XB_XSUB(j)  (1280 + 64 * (j))
#define XB_XGEN(j)  (2304 + 64 * (j))
#define XB_TOP      3328
#define XB_TOPGEN   3392
#define XCD_BAR_WORDS 3456
#define XB_SPIN_CAP (1u << 18)

__device__ __forceinline__ unsigned xb_ld(unsigned* p)              { return __hip_atomic_load(p, __ATOMIC_RELAXED, __HIP_MEMORY_SCOPE_AGENT); }
__device__ __forceinline__ unsigned xb_add(unsigned* p, unsigned v) { return __hip_atomic_fetch_add(p, v, __ATOMIC_RELAXED, __HIP_MEMORY_SCOPE_AGENT); }
__device__ __forceinline__ unsigned xb_xcc_id() { return (unsigned)__builtin_amdgcn_s_getreg((3 << 11) | 20) & 0xFu; }
#define XB_SPIN(cond, bar) do { unsigned _sp = 0; while (cond) { __builtin_amdgcn_s_sleep(1); \
    if ((++_sp & 255u) == 0u) { if (xb_ld(&(bar)[XB_TMO])) break; if (_sp > XB_SPIN_CAP) { atomicAdd(&(bar)[XB_TMO], 1u); break; } } } } while (0)

struct XcdBarrier {
    unsigned* bar; unsigned x;
    volatile LAS unsigned* st;
};

__device__ __forceinline__ XcdBarrier xcd_barrier_post(unsigned* bar, volatile LAS unsigned* st) {
    XcdBarrier b; b.bar = bar; b.x = xb_xcc_id(); b.st = st;
    if (threadIdx.x == 0) (void)xb_add(&bar[XB_XCNT(b.x)], 1u);
    return b;
}
__device__ __forceinline__ void xcd_barrier_complete(unsigned* bar, unsigned x, unsigned& nloc, unsigned& nx) {
    const unsigned G = gridDim.x * gridDim.y * gridDim.z;
    unsigned sum, cnt, mine, sp = 0u;
    for (;;) {
        sum = 0u; cnt = 0u; mine = 0u;
#pragma unroll
        for (unsigned j = 0; j < 16; ++j) { const unsigned c = xb_ld(&bar[XB_XCNT(j)]); sum += c; cnt += (c > 0u) ? 1u : 0u; mine = (j == x) ? c : mine; }
        if (sum == G) break;
        __builtin_amdgcn_s_sleep(1);
        if ((++sp & 255u) == 0u) { if (xb_ld(&bar[XB_TMO])) break; if (sp > XB_SPIN_CAP) { atomicAdd(&bar[XB_TMO], 1u); break; } }
    }
    nloc = mine > 0u ? mine : 1u; nx = cnt > 0u ? cnt : 1u;
}

__device__ __forceinline__ void xcd_barrier(const XcdBarrier& b) {
    asm volatile("s_waitcnt vmcnt(0)" ::: "memory");
    __syncthreads();
    if (threadIdx.x == 0) {
        unsigned* bar = b.bar;
        __builtin_amdgcn_s_waitcnt(0);
        unsigned nloc = b.st[0], nx = b.st[1];
        if (nloc == 0u) { xcd_barrier_complete(bar, b.x, nloc, nx); b.st[0] = nloc; b.st[1] = nx; }
        const unsigned old = xb_add(&bar[XB_XSUB(b.x)], 1u);
        const unsigned gen = old / nloc;
        if (old + 1u == (gen + 1u) * nloc) {
            __builtin_amdgcn_fence(__ATOMIC_RELEASE, "agent");
            asm volatile("s_waitcnt vmcnt(0)" ::: "memory");
            const unsigned og = xb_add(&bar[XB_TOP], 1u);
            const unsigned tg = og / nx;
            if (og + 1u == (tg + 1u) * nx) xb_add(&bar[XB_TOPGEN], 1u);
            else XB_SPIN(xb_ld(&bar[XB_TOPGEN]) == tg, bar);
            __builtin_amdgcn_fence(__ATOMIC_ACQUIRE, "agent");
            xb_add(&bar[XB_XGEN(b.x)], 1u);
            asm volatile("s_waitcnt vmcnt(0)" ::: "memory");
        } else {
            XB_SPIN(xb_ld(&bar[XB_XGEN(b.x)]) == gen, bar);
            __builtin_amdgcn_fence(__ATOMIC_ACQUIRE, "agent");
            asm volatile("s_waitcnt vmcnt(0)" ::: "memory");
        }
    }
    __syncthreads();
}


__device__ __forceinline__ void p6_norm_ab(const Args& a, LAS unsigned char* lds) {
    const int tid = threadIdx.x, lane = tid & 63, wave = tid >> 6;
    const int gw = blockIdx.x * NW + wave, NGW = gridDim.x * NW;
    unsigned char* ws = a.ws;
    LAS float* Wl = (LAS float*)lds;
    { const float* wc = (const float*)a.in[12];
      for (int i = tid; i < 16 * 1024; i += NTHR) { const int k = i >> 4, c = i & 15; Wl[c * 1024 + k] = wc[(size_t)k * 4112 + 4096 + c]; } }
    __syncthreads();
    const float* X = (const float*)a.in[0]; const bf16* DL = (const bf16*)(ws + RGN(1)); float* H1 = a.out; const float* g = (const float*)a.in[11]; bf16* XN = (bf16*)(ws + RGN(0));
    float* Gb = (float*)(ws + O_G); float* Bb = (float*)(ws + O_BETA);
    const float* alog = (const float*)a.in[14]; const float* dtb = (const float*)a.in[15];
    f32x4 gv[4];
#pragma unroll
    for (int j = 0; j < 4; ++j) gv[j] = *(const f32x4*)(g + 4 * lane + 256 * j);
    f32x4 nv[4]; v2u nd[4];
    { const int m0 = gw < T_ ? gw : 0; const f32x4* xr = (const f32x4*)(X + (size_t)m0 * D_) + lane; const v2u* dr = (const v2u*)(DL + (size_t)m0 * D_) + lane;
#pragma unroll
      for (int j = 0; j < 4; ++j) { nv[j] = __builtin_nontemporal_load(xr + 64 * j); nd[j] = __builtin_nontemporal_load(dr + 64 * j); } }
    for (int m = gw; m < T_; m += NGW) {
        f32x4 v[4]; float s = 0.f;
        { const int mn = (m + NGW < T_) ? m + NGW : m; const f32x4* xn = (const f32x4*)(X + (size_t)mn * D_) + lane; const v2u* dn = (const v2u*)(DL + (size_t)mn * D_) + lane;
#pragma unroll
          for (int j = 0; j < 4; ++j) { v[j].x = nv[j].x + bflo(nd[j].x); v[j].y = nv[j].y + bfhi(nd[j].x); v[j].z = nv[j].z + bflo(nd[j].y); v[j].w = nv[j].w + bfhi(nd[j].y); nv[j] = __builtin_nontemporal_load(xn + 64 * j); nd[j] = __builtin_nontemporal_load(dn + 64 * j); } }
        { f32x4* hw = (f32x4*)(H1 + (size_t)m * D_) + lane;
#pragma unroll
          for (int j = 0; j < 4; ++j) __builtin_nontemporal_store(v[j], hw + 64 * j); }
#pragma unroll
        for (int j = 0; j < 4; ++j) s += (v[j].x * v[j].x + v[j].y * v[j].y) + (v[j].z * v[j].z + v[j].w * v[j].w);
        const float rs = rsqrtf(wave_sum(s) * (1.f / D_) + EPS);
        v2u* o8 = (v2u*)(XN + (size_t)m * D_) + lane;
#pragma unroll
        for (int j = 0; j < 4; ++j) { v[j] = v[j] * rs * gv[j]; v2u o; o.x = pk2(v[j].x, v[j].y); o.y = pk2(v[j].z, v[j].w); o8[64 * j] = o; }
        asm volatile("" ::: "memory");
        float acc[16];
#pragma unroll
        for (int c = 0; c < 16; ++c) { float s2 = 0.f;
#pragma unroll
            for (int j = 0; j < 4; ++j) { const f32x4 w = *(const LAS f32x4*)(Wl + c * 1024 + 256 * j + 4 * lane); s2 += (v[j].x * w.x + v[j].y * w.y) + (v[j].z * w.z + v[j].w * w.w); }
            acc[c] = s2; }
        float r8[8], r4[4], r2[2], mine;
        { const bool hi = lane & 32;
#pragma unroll
          for (int c = 0; c < 8; ++c) { const float snd = hi ? acc[c] : acc[8 + c]; const float kp = hi ? acc[8 + c] : acc[c]; r8[c] = kp + __shfl_xor(snd, 32); } }
        { const bool hi = lane & 16;
#pragma unroll
          for (int c = 0; c < 4; ++c) { const float snd = hi ? r8[c] : r8[4 + c]; const float kp = hi ? r8[4 + c] : r8[c]; r4[c] = kp + __shfl_xor(snd, 16); } }
        { const bool hi = lane & 8;
#pragma unroll
          for (int c = 0; c < 2; ++c) { const float snd = hi ? r4[c] : r4[2 + c]; const float kp = hi ? r4[2 + c] : r4[c]; r2[c] = kp + __shfl_xor(snd, 8); } }
        { const bool hi = lane & 4; const float snd = hi ? r2[0] : r2[1]; const float kp = hi ? r2[1] : r2[0]; mine = kp + __shfl_xor(snd, 4); }
        mine += __shfl_xor(mine, 2); mine += __shfl_xor(mine, 1);
        const int colc = lane >> 2;
        if ((lane & 3) == 0) {
            if (colc < 8) { const float xx = mine + dtb[colc]; const float sp = fmaxf(xx, 0.f) + __logf(1.f + __expf(-fabsf(xx))); Gb[(size_t)m * 8 + colc] = -__expf(alog[colc]) * sp; }
            else { Bb[(size_t)m * 8 + colc - 8] = __builtin_amdgcn_rcpf(1.f + __expf(-mine)); } }
    }
}

__device__ __forceinline__ void p8a_conv(const Args& a) {
    const int tid = threadIdx.x, lane = tid & 63, wave = tid >> 6;
    const int gw = blockIdx.x * NW + wave, NGW = gridDim.x * NW;
    unsigned char* ws = a.ws; const float* cw = (const float*)a.in[13];
    for (int it = gw; it < 2048 * 6; it += NGW) {
        const int grp = it / 6, sub = it % 6, which = sub >> 1, half = sub & 1;
        const int col = half * 512 + 8 * lane, ch = which * 1024 + col;
        const bf16* src = (const bf16*)(ws + RGN(1 + which)); bf16* dst = (bf16*)(ws + (which == 0 ? RGN(5) : which == 1 ? RGN(6) : RGN(0)));
        const int t0 = grp * 16, ts0 = t0 & (S_ - 1);
        float w[4][8];
#pragma unroll
        for (int j = 0; j < 4; ++j) { const f32x4 w0 = *(const f32x4*)(cw + (size_t)j * 3072 + ch), w1 = *(const f32x4*)(cw + (size_t)j * 3072 + ch + 4);
            w[j][0] = w0.x; w[j][1] = w0.y; w[j][2] = w0.z; w[j][3] = w0.w; w[j][4] = w1.x; w[j][5] = w1.y; w[j][6] = w1.z; w[j][7] = w1.w; }
        v4u xr[19];
#pragma unroll
        for (int i = 0; i < 19; ++i) { const v4u z4 = {0u, 0u, 0u, 0u}; const bool ok = (i >= 3 || ts0 > 0); const int ti = ok ? t0 - 3 + i : t0;
            const v4u ld = __builtin_nontemporal_load((const v4u*)(src + (size_t)ti * 1024 + col)); xr[i] = ok ? ld : z4; }
#pragma unroll
        for (int o = 0; o < 16; ++o) {
            float y[8];
#pragma unroll
            for (int e = 0; e < 8; ++e) y[e] = 0.f;
#pragma unroll
            for (int j = 0; j < 4; ++j) { const v4u v = xr[o + j];
                y[0] += w[j][0] * bflo(v.x); y[1] += w[j][1] * bfhi(v.x); y[2] += w[j][2] * bflo(v.y); y[3] += w[j][3] * bfhi(v.y);
                y[4] += w[j][4] * bflo(v.z); y[5] += w[j][5] * bfhi(v.z); y[6] += w[j][6] * bflo(v.w); y[7] += w[j][7] * bfhi(v.w); }
            float ss = 0.f;
#pragma unroll
            for (int e = 0; e < 8; ++e) { y[e] = silu(y[e]); ss += y[e] * y[e]; }
            float sc = 1.f;
            if (which < 2) { ss = row16_sum(ss);
                sc = rsqrtf(ss + EPS); if (which == 0) sc *= 0.08838834764831845f; }
            v4u ov; ov.x = pk2(y[0] * sc, y[1] * sc); ov.y = pk2(y[2] * sc, y[3] * sc); ov.z = pk2(y[4] * sc, y[5] * sc); ov.w = pk2(y[6] * sc, y[7] * sc);
            *(v4u*)(dst + (size_t)(t0 + o) * 1024 + col) = ov;
        }
    }
}

constexpr int TS = 272, TILE = 17408, L_SET = 2 * TILE, L_M = 2 * L_SET, L_GC = L_M + 4 * TILE;
#define MFMA16(A, B, C) __builtin_amdgcn_mfma_f32_16x16x32_bf16(A, B, C, 0, 0, 0)
__device__ __forceinline__ void p8b_chunk(const Args& a, LAS unsigned char* lds) {
    const int tid0 = threadIdx.x;
    unsigned char* ws = a.ws;
    bf16* QN = (bf16*)(ws + RGN(5)); bf16* KN = (bf16*)(ws + RGN(6)); const bf16* VN = (const bf16*)(ws + RGN(0));
    bf16* KDT = (bf16*)(ws + RGN(1)); bf16* ATT = (bf16*)(ws + RGN(2)); bf16* UT = (bf16*)(ws + RGN(3));
    bf16* QOUT = a.dry ? KDT : QN; bf16* WOUT = a.dry ? UT : KN;
    const float* Gb = (const float*)(ws + O_G); const float* Bb = (const float*)(ws + O_BETA); float* GL = (float*)(ws + O_GL);
    for (int base = blockIdx.x * 4; base < 4096; base += gridDim.x * 4) {
        int tid = tid0; asm volatile("" : "+v"(tid));
        const int lane = tid & 63, wave = __builtin_amdgcn_readfirstlane(tid >> 6), c = lane & 15, g = lane >> 4;
        const int bh = base >> 7, b = bh >> 3, h = bh & 7;
        const size_t tokb = (size_t)b * S_ + (size_t)(base & 127) * 64;
        const int r0 = tid >> 4, ch = tid & 15;
        if (wave < 4) { LAS float* gcs = (LAS float*)(lds + L_GC + wave * 1024); const size_t t0 = tokb + wave * 64;
            float gv = Gb[(t0 + lane) * 8 + h];
#pragma unroll
            for (int o = 1; o < 64; o <<= 1) { const float t = __shfl_up(gv, o); if (lane >= o) gv += t; }
            const float g63 = __shfl(gv, 63);
            gcs[lane] = gv; gcs[64 + lane] = __expf(gv); gcs[128 + lane] = Bb[(t0 + lane) * 8 + h]; gcs[192 + lane] = __expf(g63 - gv);
            if (lane == 63) GL[base + wave] = __expf(gv); }
        v4u pa0, pa1, pb0, pb1;
        { const size_t go = (tokb + r0) * 1024 + h * 128 + ch * 8;
          pa0 = __builtin_nontemporal_load((const v4u*)(QN + go)); pa1 = __builtin_nontemporal_load((const v4u*)(QN + go + 32 * 1024)); pb0 = *(const v4u*)(KN + go); pb1 = *(const v4u*)(KN + go + 32 * 1024);
          *(LAS v4u*)(lds + r0 * TS + ch * 16) = pa0; *(LAS v4u*)(lds + (r0 + 32) * TS + ch * 16) = pa1;
          *(LAS v4u*)(lds + TILE + r0 * TS + ch * 16) = pb0; *(LAS v4u*)(lds + TILE + (r0 + 32) * TS + ch * 16) = pb1; }
        __syncthreads();
#pragma unroll 1
        for (int bc = 0; bc < 4; ++bc) {
            const int cidx = base + bc;
            if (bc < 3) { const size_t go = (tokb + (bc + 1) * 64 + r0) * 1024 + h * 128 + ch * 8;
                pa0 = __builtin_nontemporal_load((const v4u*)(QN + go)); pa1 = __builtin_nontemporal_load((const v4u*)(QN + go + 32 * 1024)); pb0 = *(const v4u*)(KN + go); pb1 = *(const v4u*)(KN + go + 32 * 1024); }
            const int sQ = (bc & 1) * L_SET, sK = sQ + TILE;
            LAS float* gcs = (LAS float*)(lds + L_GC + bc * 1024); LAS float* Ml = (LAS float*)(lds + L_M + bc * TILE);
#pragma unroll 1
            for (int rr = 0; rr < 4; ++rr) {
                const int tsk = wave + 8 * rr, isM = tsk >> 4, tt = tsk & 15, ib = tt >> 2, jb = tt & 3;
                const int i = 16 * ib + c, j0 = 16 * jb + 4 * g;
                const int aoff = ((ib * 2 + (jb >> 1)) * 64 + (2 * (jb & 1) + (g >> 1)) * 16 + c) * 8 + ((4 * g) & 7);
                if (jb <= ib) {
                    f32x4 acc = {0.f, 0.f, 0.f, 0.f};
                    const int xs = isM ? sK : sQ;
#pragma unroll
                    for (int ks = 0; ks < 4; ++ks) {
                        const bf16x8 A = *(const LAS bf16x8*)(lds + sK + (16 * jb + c) * TS + (32 * ks + 8 * g) * 2);
                        const bf16x8 B = *(const LAS bf16x8*)(lds + xs + (16 * ib + c) * TS + (32 * ks + 8 * g) * 2);
                        acc = MFMA16(A, B, acc); }
                    const float gi = gcs[i]; float e[4];
#pragma unroll
                    for (int ii = 0; ii < 4; ++ii) e[ii] = __expf(gi - gcs[j0 + ii]);
                    if (isM) { const float bi = gcs[128 + i]; f32x4 m;
                        m.x = (i > j0 + 0) ? bi * acc[0] * e[0] : 0.f; m.y = (i > j0 + 1) ? bi * acc[1] * e[1] : 0.f; m.z = (i > j0 + 2) ? bi * acc[2] * e[2] : 0.f; m.w = (i > j0 + 3) ? bi * acc[3] * e[3] : 0.f;
                        *(LAS f32x4*)(Ml + i * 68 + j0) = m;
                    } else { const float a0 = (i >= j0 + 0) ? acc[0] * e[0] : 0.f, a1 = (i >= j0 + 1) ? acc[1] * e[1] : 0.f, a2 = (i >= j0 + 2) ? acc[2] * e[2] : 0.f, a3 = (i >= j0 + 3) ? acc[3] * e[3] : 0.f;
                        v2u o; o.x = pk2(a0, a1); o.y = pk2(a2, a3); *(v2u*)(ATT + (size_t)cidx * 4096 + aoff) = o; }
                } else if (!isM) { const v2u o = {0u, 0u}; *(v2u*)(ATT + (size_t)cidx * 4096 + aoff) = o; }
                else { const f32x4 z = {0.f, 0.f, 0.f, 0.f}; *(LAS f32x4*)(Ml + i * 68 + j0) = z; }
            }
            for (int i2 = tid; i2 < 1024; i2 += NTHR) { const int row = i2 >> 4, cc = i2 & 15; const v4u v = *(const LAS v4u*)(lds + sQ + row * TS + cc * 16); const float e = gcs[64 + row]; v4u o;
                o.x = pk2(bflo(v.x) * e, bfhi(v.x) * e); o.y = pk2(bflo(v.y) * e, bfhi(v.y) * e); o.z = pk2(bflo(v.z) * e, bfhi(v.z) * e); o.w = pk2(bflo(v.w) * e, bfhi(v.w) * e);
                const int R = 4 * ((row >> 4) * 4 + (cc >> 2)) + (cc & 3), C = (row & 15) * 8;
                *(v4u*)(QOUT + (tokb + bc * 64 + R) * 1024 + h * 128 + C) = o; }
            if (bc < 3) { const int sn = ((bc + 1) & 1) * L_SET;
                *(LAS v4u*)(lds + sn + r0 * TS + ch * 16) = pa0; *(LAS v4u*)(lds + sn + (r0 + 32) * TS + ch * 16) = pa1;
                *(LAS v4u*)(lds + sn + TILE + r0 * TS + ch * 16) = pb0; *(LAS v4u*)(lds + sn + TILE + (r0 + 32) * TS + ch * 16) = pb1; }
            __syncthreads();
        }
        { const size_t go = (tokb + r0) * 1024 + h * 128 + ch * 8;
          pa0 = *(const v4u*)(KN + go); pa1 = *(const v4u*)(KN + go + 32 * 1024); pb0 = __builtin_nontemporal_load((const v4u*)(VN + go)); pb1 = __builtin_nontemporal_load((const v4u*)(VN + go + 32 * 1024));
          *(LAS v4u*)(lds + r0 * TS + ch * 16) = pa0; *(LAS v4u*)(lds + (r0 + 32) * TS + ch * 16) = pa1;
          *(LAS v4u*)(lds + TILE + r0 * TS + ch * 16) = pb0; *(LAS v4u*)(lds + TILE + (r0 + 32) * TS + ch * 16) = pb1; }
        if (wave < 4) {
            LAS float* Ml = (LAS float*)(lds + L_M + wave * TILE);
            float Tc[64];
            f32x4 mrow[16], mnxt[16];
#pragma unroll
            for (int i = 0; i < 64; ++i) {
#pragma unroll
                for (int j4 = 0; j4 < (i + 4) / 4 && i + 1 < 64; ++j4) mnxt[j4] = *(const LAS f32x4*)(Ml + (i + 1) * 68 + 4 * j4);
                f32x4 acc = {0.f, 0.f, 0.f, 0.f};
#pragma unroll
                for (int j4 = 0; j4 < (i + 3) / 4; ++j4) {
                    const f32x4 m = mrow[j4];
                    if (4 * j4 + 0 < i) acc.x += m.x * Tc[4 * j4 + 0];
                    if (4 * j4 + 1 < i) acc.y += m.y * Tc[4 * j4 + 1];
                    if (4 * j4 + 2 < i) acc.z += m.z * Tc[4 * j4 + 2];
                    if (4 * j4 + 3 < i) acc.w += m.w * Tc[4 * j4 + 3];
                }
                int l2 = lane; asm volatile("" : "+v"(l2));
                Tc[i] = ((l2 == i) ? 1.f : 0.f) - ((acc.x + acc.y) + (acc.z + acc.w));
#pragma unroll
                for (int j4 = 0; j4 < 16; ++j4) mrow[j4] = mnxt[j4];
            }
            asm volatile("" ::: "memory");
#pragma unroll
            for (int i = 0; i < 64; ++i) Ml[i * 68 + lane] = Tc[i];
        }
        __syncthreads();
#pragma unroll 1
        for (int bc = 0; bc < 4; ++bc) {
            const int cidx = base + bc; const size_t tok0 = tokb + bc * 64;
            if (bc < 3) { const size_t go = (tokb + (bc + 1) * 64 + r0) * 1024 + h * 128 + ch * 8;
                pa0 = *(const v4u*)(KN + go); pa1 = *(const v4u*)(KN + go + 32 * 1024); pb0 = __builtin_nontemporal_load((const v4u*)(VN + go)); pb1 = __builtin_nontemporal_load((const v4u*)(VN + go + 32 * 1024)); }
            const int sK = (bc & 1) * L_SET, sV = sK + TILE;
            LAS float* gcs = (LAS float*)(lds + L_GC + bc * 1024); LAS float* Tl = (LAS float*)(lds + L_M + bc * TILE);
            { const int db = wave, q = (lane & 15) >> 2, p = lane & 3;
              bf16x8 Kt[2], Vt[2];
#pragma unroll
              for (int ks = 0; ks < 2; ++ks) { const int off = (32 * ks + 8 * g + q) * TS + (16 * db + 4 * p) * 2;
                  Kt[ks] = cat8(vtr(lds + sK + off), vtr(lds + sK + off + 4 * TS));
                  Vt[ks] = cat8(vtr(lds + sV + off), vtr(lds + sV + off + 4 * TS)); }
#pragma unroll
              for (int ks = 0; ks < 2; ++ks) { const int jb0 = 32 * ks + 8 * g; const v4u kk = __builtin_bit_cast(v4u, Kt[ks]);
                  const f32x4 d0 = *(const LAS f32x4*)(gcs + 192 + jb0), d1 = *(const LAS f32x4*)(gcs + 192 + jb0 + 4); v4u o;
                  o.x = pk2(bflo(kk.x) * d0.x, bfhi(kk.x) * d0.y); o.y = pk2(bflo(kk.y) * d0.z, bfhi(kk.y) * d0.w); o.z = pk2(bflo(kk.z) * d1.x, bfhi(kk.z) * d1.y); o.w = pk2(bflo(kk.w) * d1.z, bfhi(kk.w) * d1.w);
                  *(v4u*)(KDT + (size_t)cidx * 8192 + ((db * 2 + ks) * 64 + lane) * 8) = o; }
              f32x4 su[2][2], sw[2][2];
#pragma unroll
              for (int ks = 0; ks < 2; ++ks)
#pragma unroll
                  for (int hf = 0; hf < 2; ++hf) { su[ks][hf] = *(const LAS f32x4*)(gcs + 128 + 32 * ks + 8 * g + 4 * hf); sw[ks][hf] = su[ks][hf] * *(const LAS f32x4*)(gcs + 64 + 32 * ks + 8 * g + 4 * hf); }
#pragma unroll
              for (int ib = 0; ib < 4; ++ib) {
                  f32x4 aw = {0.f, 0.f, 0.f, 0.f}, au = {0.f, 0.f, 0.f, 0.f};
#pragma unroll
                  for (int ks = 0; ks < 2; ++ks) {
                      const f32x4 t0 = *(const LAS f32x4*)(Tl + (16 * ib + c) * 68 + 32 * ks + 8 * g), t1 = *(const LAS f32x4*)(Tl + (16 * ib + c) * 68 + 32 * ks + 8 * g + 4);
                      const f32x4 w0 = t0 * sw[ks][0], w1 = t1 * sw[ks][1], u0 = t0 * su[ks][0], u1 = t1 * su[ks][1];
                      const bf16x8 Bw = pack8(w0.x, w0.y, w0.z, w0.w, w1.x, w1.y, w1.z, w1.w);
                      const bf16x8 Au = pack8(u0.x, u0.y, u0.z, u0.w, u1.x, u1.y, u1.z, u1.w);
                      aw = MFMA16(Kt[ks], Bw, aw); au = MFMA16(Au, Vt[ks], au); }
                  { v2u o; o.x = pk2(aw[0], aw[1]); o.y = pk2(aw[2], aw[3]); const int R = 4 * (ib * 4 + (db >> 1)) + ((2 * db + (g >> 1)) & 3), C = c * 8 + ((4 * g) & 7);
                    *(v2u*)(WOUT + (tok0 + R) * 1024 + h * 128 + C) = o; }
                  { v2u o; o.x = pk2(au[0], au[1]); o.y = pk2(au[2], au[3]); *(v2u*)(UT + (size_t)cidx * 8192 + ((db * 4 + ib) * 64 + lane) * 4) = o; }
              }
            }
            if (bc < 3) { const int sn = ((bc + 1) & 1) * L_SET;
                *(LAS v4u*)(lds + sn + r0 * TS + ch * 16) = pa0; *(LAS v4u*)(lds + sn + (r0 + 32) * TS + ch * 16) = pa1;
                *(LAS v4u*)(lds + sn + TILE + r0 * TS + ch * 16) = pb0; *(LAS v4u*)(lds + sn + TILE + (r0 + 32) * TS + ch * 16) = pb1; }
            __syncthreads();
        }
    }
}

__device__ __forceinline__ void p9_scan(const Args& a, LAS unsigned char* lds) {
    const int tid = threadIdx.x, lane = tid & 63, wave = __builtin_amdgcn_readfirstlane(tid >> 6), c = lane & 15, g = lane >> 4;
    unsigned char* ws = a.ws;
    const bf16* QD = (const bf16*)(ws + RGN(5)); const bf16* W = (const bf16*)(ws + RGN(6)); const bf16* KDT = (const bf16*)(ws + RGN(1));
    const bf16* ATT = (const bf16*)(ws + RGN(2)); const bf16* UT = (const bf16*)(ws + RGN(3)); bf16* O = (bf16*)(ws + RGN(0)); const float* GL = (const float*)(ws + O_GL);
    const bool first = wave < 4; const int wq = wave & 3;
    constexpr int L_ST = 0, L_VT = 4352;
    for (int it = blockIdx.x; it < 256; it += gridDim.x) {
        const int xcd = it & 7, jj = it >> 3, bh = xcd * 4 + (jj >> 3), slice = jj & 7, b = bh >> 3, h = bh & 7;
        __syncthreads();
        for (int i = tid; i < 4352 / 4; i += NTHR) ((LAS unsigned*)(lds + L_ST))[i] = 0u;
        if (tid < 128) ((LAS float*)(lds + 8192))[tid] = GL[bh * 128 + tid];
        __syncthreads();
        f32x4 Sacc = {0.f, 0.f, 0.f, 0.f};
        const bf16* Ap = (first ? W : QD) + ((size_t)b * S_ + 16 * wq + g) * 1024 + h * 128 + c * 8;
        const bf16* Up = UT + (size_t)(bh * 128) * 8192 + ((slice * 4 + wq) * 64 + lane) * 4;
        const bf16* Xp = ATT + (size_t)(bh * 128) * 4096 + ((wq * 2) * 64 + lane) * 8;
        const size_t ustep = first ? 8192 : 0, xstep = first ? 0 : 4096;
        const bf16* Kp = KDT + (size_t)(bh * 128) * 8192 + ((wave * 2) * 64 + lane) * 8;
        const bool dummy_st = first;
        bf16* Op = dummy_st ? (bf16*)(ws + RGN(2) + 32 * MiB) + (size_t)(blockIdx.x * 8 + wave) * 4096 + lane : O + ((size_t)b * S_ + 16 * wq + 4 * g) * 1024 + h * 128 + slice * 16 + c;
        const size_t ostep = dummy_st ? 0 : 65536;
        const int vtoff = first ? L_VT + c * 144 + (16 * wq + 4 * g) * 2 : L_VT + 2304 + lane * 8;
        bf16x8 Af[4][4], Xf[4][2], Kd[4][2]; v2u uu[4]; float gl[4];
#define SCAN_LOAD(slot, nn) do { \
            _Pragma("unroll") for (int ks = 0; ks < 4; ++ks) Af[slot][ks] = *(const bf16x8*)(Ap + (size_t)(nn) * 65536 + 4096 * ks); \
            _Pragma("unroll") for (int ks = 0; ks < 2; ++ks) Kd[slot][ks] = *(const bf16x8*)(Kp + (size_t)(nn) * 8192 + 512 * ks); \
            uu[slot] = __builtin_nontemporal_load((const v2u*)(Up + (size_t)(nn) * ustep)); Xf[slot][0] = *(const bf16x8*)(Xp + (size_t)(nn) * xstep); Xf[slot][1] = *(const bf16x8*)(Xp + (size_t)(nn) * xstep + 512); \
            gl[slot] = ((const LAS float*)(lds + 8192))[nn]; } while (0)
#pragma unroll
        for (int s4 = 0; s4 < 4; ++s4) { SCAN_LOAD(s4, s4); __builtin_amdgcn_sched_barrier(0); }
#pragma unroll 1
        for (int n0 = 0; n0 < 128; n0 += 4) {
#pragma unroll
            for (int s4 = 0; s4 < 4; ++s4) {
                const int n = n0 + s4;
                f32x4 acc = {0.f, 0.f, 0.f, 0.f}, acc2 = {0.f, 0.f, 0.f, 0.f};
                { const bf16x8 S0 = *(const LAS bf16x8*)(lds + L_ST + c * 272 + (8 * g) * 2), S1 = *(const LAS bf16x8*)(lds + L_ST + c * 272 + (32 + 8 * g) * 2);
                  const bf16x8 S2 = *(const LAS bf16x8*)(lds + L_ST + c * 272 + (64 + 8 * g) * 2), S3 = *(const LAS bf16x8*)(lds + L_ST + c * 272 + (96 + 8 * g) * 2);
                  acc = MFMA16(Af[s4][0], S0, acc); acc2 = MFMA16(Af[s4][1], S1, acc2); acc = MFMA16(Af[s4][2], S2, acc); acc2 = MFMA16(Af[s4][3], S3, acc2); acc = acc + acc2; }
                { v2u o; o.x = pk2(bflo(uu[s4].x) - acc[0], bfhi(uu[s4].x) - acc[1]); o.y = pk2(bflo(uu[s4].y) - acc[2], bfhi(uu[s4].y) - acc[3]);
                    *(LAS v2u*)(lds + vtoff) = o; }
                __syncthreads();
                bf16x8 Vb[2];
#pragma unroll
                for (int ks = 0; ks < 2; ++ks) Vb[ks] = *(const LAS bf16x8*)(lds + L_VT + c * 144 + (32 * ks + 8 * g) * 2);
                { acc = MFMA16(Xf[s4][0], Vb[0], acc); acc = MFMA16(Xf[s4][1], Vb[1], acc);
                    bf16* op = Op + (size_t)n * ostep; const unsigned p01 = pk2(acc[0], acc[1]), p23 = pk2(acc[2], acc[3]);
                    op[0] = (bf16)(p01 & 0xffffu); op[1024] = (bf16)(p01 >> 16); op[2048] = (bf16)(p23 & 0xffffu); op[3072] = (bf16)(p23 >> 16); }
                Sacc = Sacc * gl[s4];
                Sacc = MFMA16(Kd[s4][0], Vb[0], Sacc); Sacc = MFMA16(Kd[s4][1], Vb[1], Sacc);
                { v2u o; o.x = pk2(Sacc[0], Sacc[1]); o.y = pk2(Sacc[2], Sacc[3]); *(LAS v2u*)(lds + L_ST + c * 272 + (16 * wave + 4 * g) * 2) = o; }
                const int nl = (n + 4 < 128) ? n + 4 : n;
                SCAN_LOAD(s4, nl);
                __syncthreads();
            }
        }
#undef SCAN_LOAD
    }
}

__device__ __forceinline__ void p10_gate(const Args& a) {
    const int tid = threadIdx.x, lane = tid & 63, wave = tid >> 6;
    const int gw = blockIdx.x * NW + wave, NGW = gridDim.x * NW;
    unsigned char* ws = a.ws;
    const bf16* O = (const bf16*)(ws + RGN(0)); const bf16* Z = (const bf16*)(ws + RGN(4)); bf16* Y1 = (bf16*)(ws + RGN(1));
    const float* on = (const float*)a.in[16];
    float gn[16];
#pragma unroll
    for (int e = 0; e < 16; ++e) gn[e] = on[(16 * lane + e) & 127];
    for (int m = gw; m < T_; m += NGW) {
        const size_t off = (size_t)m * 1024 + 16 * lane;
        const v4u o0 = __builtin_nontemporal_load((const v4u*)(O + off)), o1 = __builtin_nontemporal_load((const v4u*)(O + off + 8)), z0 = __builtin_nontemporal_load((const v4u*)(Z + off)), z1 = __builtin_nontemporal_load((const v4u*)(Z + off + 8));
        float ov[16] = {bflo(o0.x), bfhi(o0.x), bflo(o0.y), bfhi(o0.y), bflo(o0.z), bfhi(o0.z), bflo(o0.w), bfhi(o0.w), bflo(o1.x), bfhi(o1.x), bflo(o1.y), bfhi(o1.y), bflo(o1.z), bfhi(o1.z), bflo(o1.w), bfhi(o1.w)};
        const float zv[16] = {bflo(z0.x), bfhi(z0.x), bflo(z0.y), bfhi(z0.y), bflo(z0.z), bfhi(z0.z), bflo(z0.w), bfhi(z0.w), bflo(z1.x), bfhi(z1.x), bflo(z1.y), bfhi(z1.y), bflo(z1.z), bfhi(z1.z), bflo(z1.w), bfhi(z1.w)};
        float ss = 0.f;
#pragma unroll
        for (int e = 0; e < 16; ++e) ss += ov[e] * ov[e];
        ss += __shfl_xor(ss, 1); ss += __shfl_xor(ss, 2); ss += __shfl_xor(ss, 4);
        const float rs = rsqrtf(ss * (1.f / 128.f) + EPS);
#pragma unroll
        for (int e = 0; e < 16; ++e) ov[e] = ov[e] * rs * gn[e] * silu(zv[e]);
        v4u r0, r1; r0.x = pk2(ov[0], ov[1]); r0.y = pk2(ov[2], ov[3]); r0.z = pk2(ov[4], ov[5]); r0.w = pk2(ov[6], ov[7]);
        r1.x = pk2(ov[8], ov[9]); r1.y = pk2(ov[10], ov[11]); r1.z = pk2(ov[12], ov[13]); r1.w = pk2(ov[14], ov[15]);
        *(v4u*)(Y1 + off) = r0; *(v4u*)(Y1 + off + 8) = r1;
    }
}

__device__ __forceinline__ void p12_final(const Args& a) {
    const int tid = threadIdx.x, lane = tid & 63, wave = tid >> 6;
    const int gw = blockIdx.x * NW + wave, NGW = gridDim.x * NW;
    const float* g = (const float*)a.in[18];
    f32x4 gv[4];
#pragma unroll
    for (int j = 0; j < 4; ++j) gv[j] = *(const f32x4*)(g + 4 * lane + 256 * j);
    const bf16* DL = (const bf16*)(a.ws + RGN(2));
    f32x4 nv[4]; v2u nd[4];
    { const int m0 = gw < T_ ? gw : 0; const f32x4* xr0 = (const f32x4*)(a.out + (size_t)m0 * D_) + lane; const v2u* dr = (const v2u*)(DL + (size_t)m0 * D_) + lane;
#pragma unroll
      for (int j = 0; j < 4; ++j) { nv[j] = __builtin_nontemporal_load(xr0 + 64 * j); nd[j] = __builtin_nontemporal_load(dr + 64 * j); } }
    for (int m = gw; m < T_; m += NGW) {
        f32x4* xw = (f32x4*)(a.out + (size_t)m * D_) + lane; f32x4 v[4]; float s = 0.f;
        { const int mn = (m + NGW < T_) ? m + NGW : m; const f32x4* xn = (const f32x4*)(a.out + (size_t)mn * D_) + lane; const v2u* dn = (const v2u*)(DL + (size_t)mn * D_) + lane;
#pragma unroll
          for (int j = 0; j < 4; ++j) { v[j].x = nv[j].x + bflo(nd[j].x); v[j].y = nv[j].y + bfhi(nd[j].x); v[j].z = nv[j].z + bflo(nd[j].y); v[j].w = nv[j].w + bfhi(nd[j].y); nv[j] = __builtin_nontemporal_load(xn + 64 * j); nd[j] = __builtin_nontemporal_load(dn + 64 * j); } }
#pragma unroll
        for (int j = 0; j < 4; ++j) s += (v[j].x * v[j].x + v[j].y * v[j].y) + (v[j].z * v[j].z + v[j].w * v[j].w);
        const float rs = rsqrtf(wave_sum(s) * (1.f / D_) + EPS);
#pragma unroll
        for (int j = 0; j < 4; ++j) __builtin_nontemporal_store(v[j] * rs * gv[j], xw + 64 * j);
    }
}

constexpr int NPH = 13;
__global__ void __launch_bounds__(NTHR, 2) fwd(Args a) {
    extern __shared__ __attribute__((aligned(16))) unsigned char smem[];
    LAS unsigned char* lds = (LAS unsigned char*)smem;
    cg::grid_group grid = cg::this_grid();
    unsigned char* ws = a.ws;
    const int G = gridDim.x, bx = blockIdx.x;
#define IN(k) (a.ph_lo <= (k) && (k) < a.ph_hi)
    volatile LAS unsigned* xst = (volatile LAS unsigned*)(lds + LDS_BYTES - 16);
    if (threadIdx.x < 4) xst[threadIdx.x] = 0u;
    __syncthreads();
    XcdBarrier xbar; xbar.bar = (unsigned*)(ws + O_BAR); xbar.x = 0; xbar.st = xst;
#define SEAM(k) do { if (IN(k) && IN((k) + 1)) xcd_barrier(xbar); } while (0)
    if (IN(0) && IN(1)) { if (blockIdx.x == 0) for (int i = threadIdx.x; i < XCD_BAR_WORDS; i += NTHR) ((unsigned*)(ws + O_BAR))[i] = 0u;
                          grid.sync(); xbar = xcd_barrier_post((unsigned*)(ws + O_BAR), xst); }
    if (IN(0)) p0_prologue(a, lds);
    SEAM(0);
    if (IN(1)) { pg8::Gemm g{(const bf16*)(ws + RGN(0)), (const bf16*)(ws + O_WIN0), T_, 2048, 1024}; pg8::StaticOrder S; S.init(T_, 2048, G, bx);
        pg8::EpiB E{(bf16*)(ws + RGN(1)), P0LD, 0, 0}; pg8::gemm_phase<pg8::EpiB, pg8::StaticOrder, true, true>(lds, g, S, E); }
    SEAM(1);
    if (IN(2)) p2_prep(a);
    SEAM(2);
    if (IN(3)) {
        { pg8::Gemm g{(const bf16*)(ws + RGN(5)), (const bf16*)(ws + O_WQKV), T_, 1792, 384}; pg8::StaticOrder S; S.init(T_, 1792, G, bx);
          pg8::EpiB E{(bf16*)(ws + O_QKV), 1792, 0, 0}; pg8::gemm_phase<pg8::EpiB, pg8::StaticOrder, true, true>(lds, g, S, E); }
        { pg8::Gemm g{(const bf16*)(ws + RGN(5) + 26 * MiB), (const bf16*)(ws + O_WPOOL), T_, 512, 512}; pg8::StaticOrder S; S.init(T_, 512, G, bx);
          pg8::EpiGate E{(bf16*)(ws + RGN(0)) + 512, 1024, (const bf16*)(ws + RGN(1)) + 1440, P0LD, (const float*)a.in[9]};
          pg8::gemm_phase<pg8::EpiGate, pg8::StaticOrder, true, true>(lds, g, S, E); }
    }
    SEAM(3);
    if (IN(4)) p4_attn(a, lds);
    SEAM(4);
    if (IN(5)) { pg8::Gemm g{(const bf16*)(ws + RGN(0)), (const bf16*)(ws + O_WOUTAB), T_, 1024, 1024}; pg8::StaticOrder S; S.init(T_, 1024, G, bx);
        pg8::EpiB E{(bf16*)(ws + RGN(1)), 1024, 0, 0}; pg8::gemm_phase<pg8::EpiB, pg8::StaticOrder, true, true>(lds, g, S, E); }
    SEAM(5);
    if (IN(6)) p6_norm_ab(a, lds);
    SEAM(6);
    if (IN(7)) { pg8::Gemm g{(const bf16*)(ws + RGN(0)), (const bf16*)(ws + O_WINC), T_, 4096, 1024}; pg8::StaticOrder S; S.init(T_, 4096, G, bx);
        pg8::EpiB E{(bf16*)(ws + RGN(1)), 1024, 1024, REG / 2}; pg8::gemm_phase<pg8::EpiB, pg8::StaticOrder, true, true>(lds, g, S, E); }
    SEAM(7);
    if (IN(8)) p8a_conv(a);
    SEAM(8);
    if (IN(9)) p8b_chunk(a, lds);
    SEAM(9);
    if (IN(10)) p9_scan(a, lds);
    SEAM(10);
    if (IN(11)) p10_gate(a);
    SEAM(11);
    if (IN(12)) { pg8::Gemm g{(const bf16*)(ws + RGN(1)), (const bf16*)(ws + O_WOUTC), T_, 1024, 1024}; pg8::StaticOrder S; S.init(T_, 1024, G, bx);
        pg8::EpiB E{(bf16*)(ws + RGN(2)), 1024, 0, 0}; pg8::gemm_phase<pg8::EpiB, pg8::StaticOrder, true, true>(lds, g, S, E); }
    SEAM(12);
    if (IN(13)) p12_final(a);
}

#ifndef MK_MULTI
#define MK_MULTI 0
#endif
extern "C" void kernel_launch(void* const* d_in, const int* in_sizes, int n_in, void* d_out, int out_size, void* d_ws, size_t ws_size, hipStream_t stream) {
    static int grid = 0;
    if (grid == 0) {
        if (n_in != 19 || out_size != T_ * D_ || ws_size < WS_NEED) { fprintf(stderr, "kernel_launch: unexpected shapes (n_in %d out %d ws %zu need %zu)\n", n_in, out_size, ws_size, (size_t)WS_NEED); grid = -1; return; }
        int dev = 0, cus = 0, per_cu = 0;
        hipGetDevice(&dev); hipDeviceGetAttribute(&cus, hipDeviceAttributeMultiprocessorCount, dev);
        if (hipFuncSetAttribute((const void*)fwd, hipFuncAttributeMaxDynamicSharedMemorySize, LDS_BYTES) != hipSuccess) { fprintf(stderr, "kernel_launch: hipFuncSetAttribute failed\n"); grid = -1; return; }
        hipOccupancyMaxActiveBlocksPerMultiprocessor(&per_cu, (const void*)fwd, NTHR, LDS_BYTES);
        (void)hipGetLastError();
        if (per_cu < 1) per_cu = 1;
        grid = cus * 1;
        if (grid > 256) grid = 256;
    }
    if (grid < 0) return;
    Args a{};
    for (int i = 0; i < 19; ++i) a.in[i] = d_in[i];
    a.out = (float*)d_out; a.ws = (unsigned char*)d_ws;
    for (int i = 0; i < 16; ++i) a.inv_freq[i] = 1.0f / powf(10000.0f, (float)i / 16.0f);
#if MK_MULTI
#ifndef PROBE_PH
#define PROBE_PH -1
#endif
#ifndef PROBE_REPS
#define PROBE_REPS 0
#endif
    for (int p = 0; p <= NPH; ++p) { const int reps = 1 + (p == PROBE_PH ? PROBE_REPS : 0);
        for (int r = 0; r < reps; ++r) { a.ph_lo = p; a.ph_hi = p + 1; a.dry = (p == 9 && r + 1 < reps) ? 1 : 0;
#ifdef PROBE_DRYMODE
            if (p == 10 && r + 1 < reps) a.dry = PROBE_DRYMODE;
#endif
            hipLaunchKernelGGL(fwd, dim3(grid), dim3(NTHR), LDS_BYTES, stream, a); } }
#else
    a.ph_lo = 0; a.ph_hi = NPH + 1;
    void* args[] = {&a};
    hipError_t e = hipLaunchCooperativeKernel((const void*)fwd, dim3(grid), dim3(NTHR), args, LDS_BYTES, stream);
    if (e != hipSuccess) fprintf(stderr, "cooperative launch failed: %s (grid %d)\n", hipGetErrorString(e), grid);
#endif
}
```
